# Optimizing an MI355X kernel written in HIP

```python
import jax, jax.numpy as jnp
from jax import lax
import numpy as np

D_MODEL = 1024
BATCH = 4
SEQ = 8192
DEPTH = 4

A_HEADS = 16
A_KV_HEADS = 4
A_HEAD_DIM = 64
A_REP = A_HEADS // A_KV_HEADS
IDX_HEADS = 8
IDX_DIM = 64
IDX_TOPK_MAX = 256
Q_BLOCK = 128
A_Q = A_HEADS * A_HEAD_DIM
A_KV = A_KV_HEADS * A_HEAD_DIM
A_IN = A_Q + 2 * A_KV + IDX_HEADS * IDX_DIM + IDX_DIM + IDX_HEADS
A_SPLITS = (A_Q, A_Q + A_KV, A_Q + 2 * A_KV, A_Q + 2 * A_KV + IDX_HEADS * IDX_DIM,
            A_Q + 2 * A_KV + IDX_HEADS * IDX_DIM + IDX_DIM)

B_HEADS = 4
B_DK = D_MODEL // 2 // B_HEADS
B_DV = D_MODEL // B_HEADS
B_GATE_RANK = 16
B_GATE_TAU = 16.0
B_CHUNK = 64
B_QK = B_HEADS * B_DK
B_V = B_HEADS * B_DV
B_IN = 2 * B_QK + 2 * B_V + B_GATE_RANK
B_SPLITS = (B_QK, 2 * B_QK, 2 * B_QK + B_V, 2 * B_QK + 2 * B_V)

D_FF = 4 * D_MODEL

ROPE_THETA = 500000.0
ROT_DIM = A_HEAD_DIM // 4
LN_EPS = 1e-5
RMS_EPS = 1e-6
DN_ALPHA = (2 * DEPTH) ** 0.25
DN_BETA = (8 * DEPTH) ** -0.25
N_A_LAYERS = (DEPTH + 1) // 2
N_B_LAYERS = DEPTH // 2

kernel_name = 'hybrid_dsa_gla_deepnorm'


def layer_norm(x, g, b):
    xf = x.astype(jnp.float32)
    mu = jnp.mean(xf, axis=-1, keepdims=True)
    var = jnp.mean(jnp.square(xf - mu), axis=-1, keepdims=True)
    return ((xf - mu) * lax.rsqrt(var + LN_EPS) * g + b).astype(x.dtype)


def rotary_tables(positions):
    inv = ROPE_THETA ** (-jnp.arange(0, ROT_DIM, 2, dtype=jnp.float32) / ROT_DIM)
    ang = positions.astype(jnp.float32)[..., None] * inv
    return jnp.cos(ang), jnp.sin(ang)


def partial_rotary(t, cos, sin):
    half = cos.shape[-1]
    shape = cos.shape[:2] + (1,) * (t.ndim - 3) + (half,)
    c = cos.reshape(shape)
    s = sin.reshape(shape)
    t1 = t[..., :half].astype(jnp.float32)
    t2 = t[..., half:2 * half].astype(jnp.float32)
    return jnp.concatenate([(t1 * c - t2 * s).astype(t.dtype),
                            (t2 * c + t1 * s).astype(t.dtype),
                            t[..., 2 * half:]], axis=-1)


def dsa_mixer(x, cos, sin, w_in, w_o):
    bsz, L, _ = x.shape
    top_k = min(IDX_TOPK_MAX, L // 4)
    proj = x @ w_in
    q, k, v, iq, ik, iw = jnp.split(proj, A_SPLITS, axis=-1)
    q = partial_rotary(q.reshape(bsz, L, A_HEADS, A_HEAD_DIM), cos, sin)
    k = partial_rotary(k.reshape(bsz, L, A_KV_HEADS, A_HEAD_DIM), cos, sin)
    v = v.reshape(bsz, L, A_KV_HEADS, A_HEAD_DIM)
    iq = partial_rotary(iq.reshape(bsz, L, IDX_HEADS, IDX_DIM), cos, sin)
    ik = partial_rotary(ik, cos, sin)
    iw = iw.astype(jnp.float32) * IDX_HEADS ** -0.5
    key_idx = jnp.arange(L)

    def block(i):
        start = i * Q_BLOCK
        q_idx = start + jnp.arange(Q_BLOCK)
        iq_b = lax.dynamic_slice_in_dim(iq, start, Q_BLOCK, axis=1)
        iw_b = lax.dynamic_slice_in_dim(iw, start, Q_BLOCK, axis=1)
        s = jnp.einsum('bqhd,bsd->bqhs', iq_b, ik, preferred_element_type=jnp.float32) * IDX_DIM ** -0.5
        score = jnp.einsum('bqh,bqhs->bqs', iw_b, jax.nn.relu(s))
        causal = key_idx[None, :] <= q_idx[:, None]
        score = jnp.where(causal[None], score, -jnp.inf)
        _, sel = lax.top_k(score, top_k)
        valid = sel <= q_idx[None, :, None]
        k_sel = jax.vmap(lambda kk, ii: kk[ii])(k, sel)
        v_sel = jax.vmap(lambda vv, ii: vv[ii])(v, sel)
        q_b = lax.dynamic_slice_in_dim(q, start, Q_BLOCK, axis=1).reshape(bsz, Q_BLOCK, A_KV_HEADS, A_REP, A_HEAD_DIM)
        logits = jnp.einsum('bqgrd,bqkgd->bqgrk', q_b, k_sel, preferred_element_type=jnp.float32) * A_HEAD_DIM ** -0.5
        logits = jnp.where(valid[:, :, None, None, :], logits, -jnp.inf)
        p = jax.nn.softmax(logits, axis=-1)
        o = jnp.einsum('bqgrk,bqkgd->bqgrd', p.astype(v.dtype), v_sel)
        return o.reshape(bsz, Q_BLOCK, A_Q)

    out = lax.map(block, jnp.arange(L // Q_BLOCK))
    out = out.transpose(1, 0, 2, 3).reshape(bsz, L, A_Q)
    return out @ w_o


def gla_mixer(x, w_in, w_a2, b_a, g_norm, w_o):
    bsz, L, _ = x.shape
    n_c = L // B_CHUNK
    proj = x @ w_in
    q, k, v, r, a_low = jnp.split(proj, B_SPLITS, axis=-1)
    log_a = jax.nn.log_sigmoid((a_low @ w_a2 + b_a).astype(jnp.float32)) / B_GATE_TAU

    def to_chunks(t, d):
        return t.astype(jnp.float32).reshape(bsz, n_c, B_CHUNK, B_HEADS, d).transpose(1, 0, 3, 2, 4)

    qc = to_chunks(q, B_DK) * B_DK ** -0.5
    kc = to_chunks(k, B_DK)
    vc = to_chunks(v, B_DV)
    gc = to_chunks(log_a, B_DK)
    mask = jnp.tril(jnp.ones((B_CHUNK, B_CHUNK), dtype=bool))

    def step(state, inp):
        qi, ki, vi, gi = inp
        b = jnp.cumsum(gi, axis=2)
        b_last = b[:, :, -1:, :]
        diff = jnp.where(mask[None, None, :, :, None], b[:, :, :, None, :] - b[:, :, None, :, :], -jnp.inf)
        attn = jnp.einsum('bhid,bhjd,bhijd->bhij', qi, ki, jnp.exp(diff))
        intra = jnp.einsum('bhij,bhje->bhie', attn, vi)
        inter = jnp.einsum('bhid,bhde->bhie', qi * jnp.exp(b), state)
        new_state = jnp.exp(b_last)[:, :, 0, :, None] * state + jnp.einsum('bhjd,bhje->bhde', ki * jnp.exp(b_last - b), vi)
        return new_state, intra + inter

    state0 = jnp.zeros((bsz, B_HEADS, B_DK, B_DV), jnp.float32)
    _, outs = lax.scan(step, state0, (qc, kc, vc, gc))
    o = outs.transpose(1, 0, 3, 2, 4).reshape(bsz, L, B_HEADS, B_DV)
    o = o * lax.rsqrt(jnp.mean(jnp.square(o), axis=-1, keepdims=True) + RMS_EPS) * g_norm
    gate = jax.nn.silu(r.astype(jnp.float32).reshape(bsz, L, B_HEADS, B_DV))
    y = (o * gate).reshape(bsz, L, B_V).astype(x.dtype)
    return y @ w_o


def squared_relu_mlp(x, w_up, w_down):
    return jnp.square(jax.nn.relu(x @ w_up)) @ w_down


def setup_inputs(seed: int = 0) -> dict:
    key = jax.random.key(seed)
    ks = jax.random.split(key, 16)
    f32 = jnp.float32

    def nrm(k, shape, fan_in, scale=1.0):
        return jax.random.normal(k, shape, f32) * (scale * fan_in ** -0.5)

    x = jax.random.normal(ks[0], (BATCH, SEQ, D_MODEL), f32)
    positions = jnp.broadcast_to(jnp.arange(SEQ, dtype=jnp.int32), (BATCH, SEQ))
    a_w_in = nrm(ks[1], (N_A_LAYERS, D_MODEL, A_IN), D_MODEL)
    a_w_o = nrm(ks[2], (N_A_LAYERS, A_Q, D_MODEL), A_Q, DN_BETA)
    b_w_in = nrm(ks[3], (N_B_LAYERS, D_MODEL, B_IN), D_MODEL)
    b_w_a2 = nrm(ks[4], (N_B_LAYERS, B_GATE_RANK, B_QK), B_GATE_RANK)
    b_b_a = 0.1 * jax.random.normal(ks[5], (N_B_LAYERS, B_QK), f32)
    b_g_norm = 1.0 + 0.02 * jax.random.normal(ks[6], (N_B_LAYERS, B_DV), f32)
    b_w_o = nrm(ks[7], (N_B_LAYERS, B_V, D_MODEL), B_V, DN_BETA)
    ln_mix_g = 1.0 + 0.02 * jax.random.normal(ks[8], (DEPTH, D_MODEL), f32)
    ln_mix_b = 0.02 * jax.random.normal(ks[9], (DEPTH, D_MODEL), f32)
    mlp_w_up = nrm(ks[10], (DEPTH, D_MODEL, D_FF), D_MODEL)
    mlp_w_down = nrm(ks[11], (DEPTH, D_FF, D_MODEL), D_FF, DN_BETA)
    ln_mlp_g = 1.0 + 0.02 * jax.random.normal(ks[12], (DEPTH, D_MODEL), f32)
    ln_mlp_b = 0.02 * jax.random.normal(ks[13], (DEPTH, D_MODEL), f32)
    return {'x': x, 'positions': positions, 'a_w_in': a_w_in, 'a_w_o': a_w_o,
            'b_w_in': b_w_in, 'b_w_a2': b_w_a2, 'b_b_a': b_b_a, 'b_g_norm': b_g_norm, 'b_w_o': b_w_o,
            'ln_mix_g': ln_mix_g, 'ln_mix_b': ln_mix_b, 'mlp_w_up': mlp_w_up, 'mlp_w_down': mlp_w_down,
            'ln_mlp_g': ln_mlp_g, 'ln_mlp_b': ln_mlp_b}


def reference(x, positions, a_w_in, a_w_o, b_w_in, b_w_a2, b_b_a, b_g_norm, b_w_o,
              ln_mix_g, ln_mix_b, mlp_w_up, mlp_w_down, ln_mlp_g, ln_mlp_b):
    cos, sin = rotary_tables(positions)
    h = x
    for i in range(DEPTH):
        j = i // 2
        if i % 2 == 0:
            mix = dsa_mixer(h, cos, sin, a_w_in[j], a_w_o[j])
        else:
            mix = gla_mixer(h, b_w_in[j], b_w_a2[j], b_b_a[j], b_g_norm[j], b_w_o[j])
        h = layer_norm(DN_ALPHA * h + mix, ln_mix_g[i], ln_mix_b[i])
        h = layer_norm(DN_ALPHA * h + squared_relu_mlp(h, mlp_w_up[i], mlp_w_down[i]), ln_mlp_g[i], ln_mlp_b[i])
    return h
```

```cpp
#include <hip/hip_runtime.h>
#include <hip/hip_cooperative_groups.h>
#include <cstdio>
#include <cstdint>
namespace cg = cooperative_groups;
namespace pg8 {
#define PG8_LAS __attribute__((address_space(3)))
typedef unsigned short bf16_t;
typedef short bf16x8 __attribute__((ext_vector_type(8)));
typedef float f32x4 __attribute__((ext_vector_type(4)));
typedef unsigned u32x4 __attribute__((ext_vector_type(4)));
constexpr int BM = 256, BK = 64, HALF = 128, HTB = HALF * BK * 2  , STAGE_BYTES = 8 * HTB, NXCD = 8, WGM = 8;

__host__ __device__ __forceinline__ int lds_byte(int r, int c) { const int st = (r >> 4) * 2 + (c >> 5), rr = r & 15, cc = c & 31, ob = rr * 64 + cc * 2; return st * 1024 + (ob ^ (((ob >> 9) & 1) << 5)); }
__host__ __device__ __forceinline__ void stage_rc(int b, int& R, int& C) { const int st = b / 1024, sb = b % 1024, swz = sb ^ (((sb >> 9) & 1) << 5); R = (st >> 1) * 16 + swz / 64; C = (st & 1) * 32 + (swz % 64) / 2; }
__host__ __device__ __forceinline__ int perm32(int rho) { const int n = rho >> 4, i = rho & 15; return 8 * (i >> 2) + 4 * n + (i & 3); }

struct Unit { int pm, pn; };
struct Gemm { const bf16_t* A; const bf16_t* Bt; int M, N, K, lda; };

struct StaticOrder {
    int nM, nN, nwg, G, c;
    __host__ __device__ void init(int M, int N, int G_, int c_) { nM = M / BM; nN = N / BM; nwg = nM * nN; G = G_; c = c_; }
    __host__ __device__ bool next(int i, Unit& u) const {
        const long L = (long)i * G + c; if (L >= nwg) return false;
        int wgid = (int)L; { const int q = nwg / NXCD, r = nwg % NXCD, xcd = wgid % NXCD, off = wgid / NXCD; wgid = (xcd < r ? xcd * (q + 1) : r * (q + 1) + (xcd - r) * q) + off; }
        const int nig = WGM * nN, gid = wgid / nig, fm = gid * WGM, gsz = (nM - fm) < WGM ? (nM - fm) : WGM;
        u.pm = fm + ((wgid % nig) % gsz); u.pn = (wgid % nig) / gsz; return true;
    }
    __device__ __forceinline__ void a_ready(const Unit&) const {}
    __device__ __forceinline__ void done(const Unit&) const {}
};
__device__ __forceinline__ unsigned cvt_pk_bf16(float lo, float hi) { unsigned r; asm volatile("v_cvt_pk_bf16_f32 %0, %1, %2" : "=v"(r) : "v"(lo), "v"(hi)); return r; }
typedef float f32x2 __attribute__((ext_vector_type(2)));
struct EpiBf16R {
    static constexpr bool PERM = true, AFTER_DRAIN = false;
    bf16_t* O; int ldc; int act;
    __device__ __forceinline__ void operator()(const f32x4 (&acc)[2][2][4][2], const Unit& u, int wr, int wc, int fr, int fq) const {
        const int row0 = u.pm * BM + wr * 64 + fr; const int col0 = u.pn * BM + wc * 32 + 8 * fq;
        const f32x4 z4 = (f32x4){0.f, 0.f, 0.f, 0.f};
#pragma unroll
        for (int ai = 0; ai < 2; ++ai)
#pragma unroll
            for (int m = 0; m < 4; ++m) { bf16_t* rowp = O + (size_t)(row0 + ai * HALF + m * 16) * ldc + col0;
#pragma unroll
                for (int bj = 0; bj < 2; ++bj) { f32x4 v0 = acc[ai][bj][m][0], v1 = acc[ai][bj][m][1];
                    if (act) { v0 = __builtin_elementwise_max(v0, z4); v1 = __builtin_elementwise_max(v1, z4); v0 = v0 * v0; v1 = v1 * v1; }
                    u32x4 w; w.x = cvt_pk_bf16(v0[0], v0[1]); w.y = cvt_pk_bf16(v0[2], v0[3]); w.z = cvt_pk_bf16(v1[0], v1[1]); w.w = cvt_pk_bf16(v1[2], v1[3]);
                    *(u32x4*)(rowp + bj * HALF) = w; } }
    }
};
struct EpiResid {
    static constexpr bool PERM = false, AFTER_DRAIN = false;
    const float* base; float* out; int ldc; float alpha;
    __device__ __forceinline__ void operator()(const f32x4 (&acc)[2][2][4][2], const Unit& u, int wr, int wc, int fr, int fq) const {
        const int col0 = u.pn * BM + wc * 32 + 4 * fq;
#pragma unroll
        for (int ai = 0; ai < 2; ++ai)
#pragma unroll
            for (int m = 0; m < 4; ++m) { const size_t off = (size_t)(u.pm * BM + ai * HALF + wr * 64 + m * 16 + fr) * ldc + col0;
#pragma unroll
                for (int bj = 0; bj < 2; ++bj)
#pragma unroll
                    for (int n = 0; n < 2; ++n) { const size_t p = off + bj * HALF + n * 16; const f32x4 bs = *(const f32x4*)(base + p);
                        *(f32x4*)(out + p) = bs * alpha + acc[ai][bj][m][n]; }
                asm volatile("" ::: "memory"); }
    }
};
template <class Epi, class Sched, bool ALIGN_EPI = false, bool SP2 = false>
__device__ __forceinline__ void gemm_phase(PG8_LAS unsigned char* lds, const Gemm g, const Sched& S, const Epi& E) {
    int tid = threadIdx.x; asm volatile("" : "+v"(tid)); const int wid = __builtin_amdgcn_readfirstlane(tid >> 6), lane = tid & 63, wr = wid >> 2, wc = wid & 3, fr = lane & 15, fq = lane >> 4;
    const int K = g.K, nt = K / BK;
    unsigned voffA[2], voffB[2];
#pragma unroll
    for (int i = 0; i < 2; ++i) { int R, C; stage_rc(tid * 16 + i * 8192, R, C); const int Rb = Epi::PERM ? ((R & ~31) + perm32(R & 31)) : R;
        voffA[i] = (unsigned)(R * g.lda + C) * 2u; voffB[i] = (unsigned)(Rb * K + C) * 2u; }
    const size_t kstep = (size_t)(BK * 2);
    const size_t hstep = (size_t)HALF * K * 2; const size_t hstepA = (size_t)HALF * g.lda * 2;
    const size_t tstep = 2 * hstep; const size_t tstepA = 2 * hstepA;
    const unsigned ldsw = (unsigned)wid * 1024u;
    const int aoff = lds_byte(wr * 64 + fr, fq * 8), boff = lds_byte(wc * 32 + fr, fq * 8);
#define PG8_SA(b, h) (((b) * 2 + (h)) * HTB)
#define PG8_SB(b, h) ((4 + (b) * 2 + (h)) * HTB)
#define PG8_STAGE(bufoff, gbase, voff) do { _Pragma("unroll") for (int _i = 0; _i < 2; ++_i) \
        __builtin_amdgcn_global_load_lds((const unsigned*)((const char*)(gbase) + (voff)[_i]), (PG8_LAS unsigned*)(lds + (bufoff) + ldsw + _i * 8192), 16, 0, 0); } while (0)
#define PG8_LDA(dst, b, h) do { _Pragma("unroll") for (int m = 0; m < 4; ++m) _Pragma("unroll") for (int k = 0; k < 2; ++k) dst[m][k] = *(const PG8_LAS bf16x8*)(lds + PG8_SA(b, h) + aoff + m * 2048 + k * 1024); } while (0)
#define PG8_LDB(dst, b, h) do { _Pragma("unroll") for (int n = 0; n < 2; ++n) _Pragma("unroll") for (int k = 0; k < 2; ++k) dst[n][k] = *(const PG8_LAS bf16x8*)(lds + PG8_SB(b, h) + boff + n * 2048 + k * 1024); } while (0)
#define PG8_MMA(ai, bj, At, Bt) do { __builtin_amdgcn_s_setprio(1); _Pragma("unroll") for (int m = 0; m < 4; ++m) _Pragma("unroll") for (int n = 0; n < 2; ++n) _Pragma("unroll") for (int k = 0; k < 2; ++k) \
        acc[ai][bj][m][n] = __builtin_amdgcn_mfma_f32_16x16x32_bf16(Bt[n][k], At[m][k], acc[ai][bj][m][n], 0, 0, 0); __builtin_amdgcn_s_setprio(0); } while (0)
#define PG8_WAIT_V(n) asm volatile("s_waitcnt vmcnt(" #n ")" ::: "memory")
#define PG8_WAIT_L(n) asm volatile("s_waitcnt lgkmcnt(" #n ")" ::: "memory")
#define PG8_BAR __builtin_amdgcn_s_barrier()
#define PG8_SCHED __builtin_amdgcn_sched_barrier(0)
    Unit cur, nxt; int ui = 0;
    if (!S.next(0, cur)) return;
    f32x4 acc[2][2][4][2];
#pragma unroll
    for (int a = 0; a < 2; ++a)
#pragma unroll
        for (int b = 0; b < 2; ++b)
#pragma unroll
            for (int m = 0; m < 4; ++m)
#pragma unroll
                for (int n = 0; n < 2; ++n) acc[a][b][m][n] = (f32x4){0.f, 0.f, 0.f, 0.f};
    bf16x8 At[4][2], B0[2][2], B1[2][2];
    const char* cA = (const char*)g.A + (size_t)cur.pm * tstepA; const char* cB = (const char*)g.Bt + (size_t)cur.pn * tstep;
    S.a_ready(cur);
    if constexpr (SP2) {
        PG8_STAGE(PG8_SB(0, 0), cB, voffB); PG8_STAGE(PG8_SB(0, 1), cB + hstep, voffB); PG8_STAGE(PG8_SA(0, 0), cA, voffA); PG8_STAGE(PG8_SA(0, 1), cA + hstepA, voffA);
        if (wr == 1) PG8_BAR;
        PG8_WAIT_V(2); PG8_BAR;
        PG8_STAGE(PG8_SB(1, 0), cB + kstep, voffB); PG8_STAGE(PG8_SA(1, 0), cA + kstep, voffA); PG8_STAGE(PG8_SB(1, 1), cB + hstep + kstep, voffB);
        PG8_WAIT_V(6); PG8_BAR;
    } else {
        PG8_STAGE(PG8_SB(0, 0), cB, voffB); PG8_STAGE(PG8_SA(0, 0), cA, voffA); PG8_STAGE(PG8_SB(0, 1), cB + hstep, voffB); PG8_STAGE(PG8_SA(0, 1), cA + hstepA, voffA);
        if (wr == 1) PG8_BAR;
        PG8_WAIT_V(4); PG8_BAR;
        PG8_STAGE(PG8_SB(1, 0), cB + kstep, voffB); PG8_STAGE(PG8_SA(1, 0), cA + kstep, voffA); PG8_STAGE(PG8_SB(1, 1), cB + hstep + kstep, voffB);
        PG8_WAIT_V(6); PG8_BAR;
    }
    for (;;) {
        const bool has_next = S.next(ui + 1, nxt);
        const char* nA = has_next ? (const char*)g.A + (size_t)nxt.pm * tstepA : cA; const char* nB = has_next ? (const char*)g.Bt + (size_t)nxt.pn * tstep : cB;
        for (int t = 0; t < nt; t += 2) {
            const bool last = (t == nt - 2);
            const char* a1 = cA + (size_t)(t + 1) * kstep;
            const char* a2 = last ? nA : cA + (size_t)(t + 2) * kstep; const char* b2 = last ? nB : cB + (size_t)(t + 2) * kstep;
            const char* a3 = a2 + kstep; const char* b3 = b2 + kstep;
            if (last && has_next) S.a_ready(nxt);
            if constexpr (SP2) {
            PG8_LDB(B0, 0, 0); PG8_LDB(B1, 0, 1); PG8_SCHED; PG8_LDA(At, 0, 0); PG8_STAGE(PG8_SA(1, 1), a1 + hstepA, voffA);
            PG8_WAIT_V(8); PG8_WAIT_L(0); PG8_BAR; PG8_MMA(0, 0, At, B0); PG8_MMA(0, 1, At, B1); PG8_BAR; PG8_SCHED;
            PG8_LDA(At, 0, 1); PG8_STAGE(PG8_SB(0, 0), b2, voffB); PG8_STAGE(PG8_SB(0, 1), b2 + hstep, voffB); PG8_STAGE(PG8_SA(0, 0), a2, voffA);
            PG8_WAIT_V(8); PG8_WAIT_L(0); PG8_BAR; PG8_MMA(1, 0, At, B0); PG8_MMA(1, 1, At, B1); PG8_BAR; PG8_SCHED;
            PG8_LDB(B0, 1, 0); PG8_LDB(B1, 1, 1); PG8_SCHED; PG8_LDA(At, 1, 0); PG8_STAGE(PG8_SA(0, 1), a2 + hstepA, voffA);
            PG8_WAIT_V(8); PG8_WAIT_L(0); PG8_BAR; PG8_MMA(0, 0, At, B0); PG8_MMA(0, 1, At, B1); PG8_BAR; PG8_SCHED;
            PG8_LDA(At, 1, 1); PG8_STAGE(PG8_SB(1, 0), b3, voffB); PG8_STAGE(PG8_SB(1, 1), b3 + hstep, voffB); PG8_STAGE(PG8_SA(1, 0), a3, voffA);
            PG8_WAIT_V(8); PG8_WAIT_L(0); PG8_BAR; PG8_MMA(1, 0, At, B0); PG8_MMA(1, 1, At, B1); PG8_BAR; PG8_SCHED;
            } else {
            PG8_LDB(B0, 0, 0); PG8_SCHED; PG8_LDA(At, 0, 0); PG8_STAGE(PG8_SA(1, 1), a1 + hstepA, voffA);
            PG8_WAIT_L(8); PG8_BAR; PG8_WAIT_L(0); PG8_MMA(0, 0, At, B0); PG8_BAR; PG8_SCHED;
            PG8_LDB(B1, 0, 1); PG8_STAGE(PG8_SB(0, 0), b2, voffB);
            PG8_BAR; PG8_WAIT_L(0); PG8_MMA(0, 1, At, B1); PG8_BAR;
            PG8_LDA(At, 0, 1); PG8_STAGE(PG8_SA(0, 0), a2, voffA);
            PG8_BAR; PG8_WAIT_L(0); PG8_MMA(1, 0, At, B0); PG8_BAR; PG8_SCHED;
            PG8_STAGE(PG8_SB(0, 1), b2 + hstep, voffB);
            PG8_WAIT_V(6); PG8_BAR; PG8_MMA(1, 1, At, B1); PG8_BAR;
            PG8_LDB(B0, 1, 0); PG8_SCHED; PG8_LDA(At, 1, 0); PG8_STAGE(PG8_SA(0, 1), a2 + hstepA, voffA);
            PG8_WAIT_L(8); PG8_BAR; PG8_WAIT_L(0); PG8_MMA(0, 0, At, B0); PG8_BAR; PG8_SCHED;
            PG8_LDB(B1, 1, 1); PG8_STAGE(PG8_SB(1, 0), b3, voffB);
            PG8_BAR; PG8_WAIT_L(0); PG8_MMA(0, 1, At, B1); PG8_BAR;
            PG8_LDA(At, 1, 1); PG8_STAGE(PG8_SA(1, 0), a3, voffA);
            PG8_BAR; PG8_WAIT_L(0); PG8_MMA(1, 0, At, B0); PG8_BAR; PG8_SCHED;
            PG8_STAGE(PG8_SB(1, 1), b3 + hstep, voffB);
            PG8_WAIT_V(6); PG8_BAR; PG8_MMA(1, 1, At, B1); PG8_BAR;
            }
        }
        if constexpr (ALIGN_EPI) { if (wr == 0) PG8_BAR; }
        if constexpr (!Epi::AFTER_DRAIN) { int t2_ = threadIdx.x; asm volatile("" : "+v"(t2_)); const int w2_ = __builtin_amdgcn_readfirstlane(t2_ >> 6), l2_ = t2_ & 63; E(acc, cur, w2_ >> 2, w2_ & 3, l2_ & 15, l2_ >> 4); S.done(cur); }
        if (!has_next) break;
#pragma unroll
        for (int a = 0; a < 2; ++a)
#pragma unroll
            for (int b = 0; b < 2; ++b)
#pragma unroll
                for (int m = 0; m < 4; ++m)
#pragma unroll
                    for (int n = 0; n < 2; ++n) acc[a][b][m][n] = (f32x4){0.f, 0.f, 0.f, 0.f};
        cur = nxt; cA = nA; cB = nB; ++ui;
        if constexpr (ALIGN_EPI) { if (wr == 1) PG8_BAR; }
    }
    PG8_WAIT_V(0);
    if constexpr (!ALIGN_EPI) { if (wr == 0) PG8_BAR; }
    PG8_BAR;
    if constexpr (Epi::AFTER_DRAIN) { E.fused(acc, cur, wr, wc, fr, fq, lds, wid, lane); S.done(cur); }
#undef PG8_SA
#undef PG8_SB
#undef PG8_STAGE
#undef PG8_LDA
#undef PG8_LDB
#undef PG8_MMA
#undef PG8_WAIT_V
#undef PG8_WAIT_L
#undef PG8_BAR
#undef PG8_SCHED
}
}
#define LAS __attribute__((address_space(3)))
#define DI __device__ __forceinline__
typedef unsigned short bf16_t;
typedef short bf16x8 __attribute__((ext_vector_type(8)));
typedef short s16x4 __attribute__((ext_vector_type(4)));
typedef float f32x4 __attribute__((ext_vector_type(4)));
typedef float f32x16 __attribute__((ext_vector_type(16)));
typedef unsigned u32x4 __attribute__((ext_vector_type(4)));
typedef unsigned u32x2 __attribute__((ext_vector_type(2)));
constexpr int NTOK = 32768, DM = 1024, SEQ = 8192, FF = 4096;
constexpr int AIN = 2120, AINP = 2304, BIN = 3088, BINP = 3328;
constexpr size_t MiB = 1u << 20;
constexpr size_t WS_ROT = 1 * MiB, OFF_AIN = 4 * MiB, OFF_AO = 13 * MiB, OFF_BIN = 17 * MiB, OFF_BO = 30 * MiB, OFF_UP = 34 * MiB, OFF_DN = 66 * MiB;
constexpr size_t WS_HB = 104 * MiB, WS_R = 168 * MiB, WS_AO = 312 * MiB, WS_DS = 376 * MiB, WS_DEC = 504 * MiB, WS_END = 505 * MiB;
constexpr size_t SZ_AIN = (size_t)AINP * 1024 * 2, SZ_BIN = (size_t)BINP * 1024 * 2, SZ_SQ = 2 * MiB, SZ_FF = 8 * MiB;
constexpr int LDS_BYTES = 147456;
constexpr float DN_ALPHA = 1.681792830507429f;

#define LDS_WAIT() asm volatile("s_waitcnt lgkmcnt(0)" ::: "memory")
DI unsigned f2bf(float f) { unsigned u = __float_as_uint(f); return (u + 0x7fffu + ((u >> 16) & 1u)) >> 16; }
DI unsigned pk2(float lo, float hi) { return f2bf(lo) | (f2bf(hi) << 16); }
DI float bflo(unsigned w) { return __uint_as_float(w << 16); }
DI float bfhi(unsigned w) { return __uint_as_float(w & 0xffff0000u); }
DI float bf1(bf16_t b) { return __uint_as_float((unsigned)b << 16); }
DI float wave_sum(float v) {
#pragma unroll
    for (int o = 1; o < 64; o <<= 1) v += __shfl_xor(v, o);
    return v;
}
DI int my_tid() { int t = threadIdx.x; asm volatile("" : "+v"(t)); return t; }
DI int my_bid() { int b = blockIdx.x; asm volatile("" : "+s"(b)); return b; }
DI int my_bid_v() { int b = blockIdx.x; asm volatile("" : "+v"(b)); return b; }
DI int crow(int i, int h) { return (i & 3) + 8 * (i >> 2) + 4 * h; }
#define MFMA32(a, b, c) __builtin_amdgcn_mfma_f32_32x32x16_bf16((a), (b), (c), 0, 0, 0)
#define MFMA16(a, b, c) __builtin_amdgcn_mfma_f32_16x16x32_bf16((a), (b), (c), 0, 0, 0)

DI void transpose_matrix(const float* W, int K, int N, int Np, bf16_t* WT, LAS float* scr, int gw, int ngw, int lane) {
    const int nbn = Np >> 6, nit = (K >> 6) * nbn;
    for (int it = gw; it < nit; it += ngw) {
        const int k0 = (it / nbn) << 6, n0 = (it % nbn) << 6;
        const int n = n0 + lane; const bool ok = n < N;
        const float* src = W + (size_t)k0 * N + n;
#pragma unroll 8
        for (int kk = 0; kk < 64; ++kk) scr[kk * 65 + lane] = ok ? src[(size_t)kk * N] : 0.f;
        LDS_WAIT();
        const int c = lane & 7, nr = lane >> 3;
#pragma unroll
        for (int j = 0; j < 8; ++j) { const int nn = nr + 8 * j; const LAS float* s = scr + (8 * c) * 65 + nn;
            u32x4 o; o.x = pk2(s[0], s[65]); o.y = pk2(s[130], s[195]); o.z = pk2(s[260], s[325]); o.w = pk2(s[390], s[455]);
            *(u32x4*)(WT + (size_t)(n0 + nn) * K + k0 + 8 * c) = o; }
        LDS_WAIT();
    }
}
DI void rot_table(const int* pos, float* rot, int gtid, int gt) {
    for (int idx = gtid; idx < NTOK * 8; idx += gt) {
        const int t = idx >> 3, i = idx & 7;
        const double inv = i == 0 ? 1.0 : i == 1 ? 0.19392274474868576 : i == 2 ? 0.03760603093086393 : i == 3 ? 0.007292664737217109 : i == 4 ? 0.001414213562373095 :
                           i == 5 ? 0.0002742481756762073 : i == 6 ? 5.318295896944988e-05 : 1.031338537721246e-05;
        const double x = (double)pos[t] * inv;
        const double n = rint(x * 0.15915494309189535);
        const double r = fma(-n, 6.283185307179586, x) - n * 2.4492935982947064e-16;
        const double r2 = r * r;
        double ts = r, ss = r, tc = 1.0, sc = 1.0;
#pragma unroll
        for (int k = 1; k <= 14; ++k) { ts *= -r2 / (double)((2 * k) * (2 * k + 1)); ss += ts; tc *= -r2 / (double)((2 * k - 1) * (2 * k)); sc += tc; }
        rot[t * 16 + i] = (float)sc; rot[t * 16 + 8 + i] = (float)ss;
    }
}
DI void ln_phase(float* hbuf, bf16_t* hb, const float* g, const float* b, int gw, int ngw, int lane) {
    for (int m = gw; m < NTOK; m += ngw) {
        f32x4* row = (f32x4*)(hbuf + (size_t)m * DM) + lane; f32x4 v[4]; float s = 0.f;
#pragma unroll
        for (int j = 0; j < 4; ++j) { v[j] = row[64 * j]; s += (v[j].x + v[j].y) + (v[j].z + v[j].w); }
        const float mean = wave_sum(s) * (1.f / DM); float s2 = 0.f;
#pragma unroll
        for (int j = 0; j < 4; ++j) { v[j] = v[j] - mean; s2 += (v[j].x * v[j].x + v[j].y * v[j].y) + (v[j].z * v[j].z + v[j].w * v[j].w); }
        const float rstd = 1.f / sqrtf(wave_sum(s2) * (1.f / DM) + 1e-5f);
        u32x2* o8 = (u32x2*)(hb + (size_t)m * DM) + lane;
#pragma unroll
        for (int j = 0; j < 4; ++j) { const f32x4 gg = ((const f32x4*)g)[lane + 64 * j], bb = ((const f32x4*)b)[lane + 64 * j];
            const f32x4 o = v[j] * rstd * gg + bb; row[64 * j] = o; u32x2 w; w.x = pk2(o.x, o.y); w.y = pk2(o.z, o.w); o8[64 * j] = w; }
    }
}
DI void rotary_phase(bf16_t* proj, const float* rot, int gtid, int gt) {
    for (int idx = gtid; idx < NTOK * 29; idx += gt) {
        const int t = idx / 29, hh = idx - t * 29;
        const int col = hh < 16 ? hh * 64 : hh < 20 ? 1024 + (hh - 16) * 64 : hh < 28 ? 1536 + (hh - 20) * 64 : 2048;
        bf16_t* p = proj + (size_t)t * AINP + col;
        const u32x4 a = *(const u32x4*)p, bq = *(const u32x4*)(p + 8);
        const f32x4 c0 = *(const f32x4*)(rot + t * 16), c1 = *(const f32x4*)(rot + t * 16 + 4), s0 = *(const f32x4*)(rot + t * 16 + 8), s1 = *(const f32x4*)(rot + t * 16 + 12);
        u32x4 oa, ob;
#define ROT2(W, CA, SA, CB, SB) { const float t1a = bflo(a.W), t1b = bfhi(a.W), t2a = bflo(bq.W), t2b = bfhi(bq.W); \
        oa.W = pk2(t1a * CA - t2a * SA, t1b * CB - t2b * SB); ob.W = pk2(t2a * CA + t1a * SA, t2b * CB + t1b * SB); }
        ROT2(x, c0.x, s0.x, c0.y, s0.y) ROT2(y, c0.z, s0.z, c0.w, s0.w) ROT2(z, c1.x, s1.x, c1.y, s1.y) ROT2(w, c1.z, s1.z, c1.w, s1.w)
#undef ROT2
        *(u32x4*)p = oa; *(u32x4*)(p + 8) = ob;
    }
}
template <int OFF> DI void tr_read8(unsigned addr, s16x4 (&r)[8]) {
    asm volatile("ds_read_b64_tr_b16 %0, %8 offset:%9\n\tds_read_b64_tr_b16 %1, %8 offset:%10\n\tds_read_b64_tr_b16 %2, %8 offset:%11\n\tds_read_b64_tr_b16 %3, %8 offset:%12\n\t"
                 "ds_read_b64_tr_b16 %4, %8 offset:%13\n\tds_read_b64_tr_b16 %5, %8 offset:%14\n\tds_read_b64_tr_b16 %6, %8 offset:%15\n\tds_read_b64_tr_b16 %7, %8 offset:%16\n\ts_waitcnt lgkmcnt(0)"
                 : "=&v"(r[0]), "=&v"(r[1]), "=&v"(r[2]), "=&v"(r[3]), "=&v"(r[4]), "=&v"(r[5]), "=&v"(r[6]), "=&v"(r[7])
                 : "v"(addr), "n"(OFF), "n"(OFF + 2112), "n"(OFF + 32), "n"(OFF + 32 + 2112), "n"(OFF + 64), "n"(OFF + 64 + 2112), "n"(OFF + 96), "n"(OFF + 96 + 2112) : "memory");
}
constexpr int VROW = 528;
DI void dsa_phase(LAS unsigned char* lds, const bf16_t* proj, bf16_t* ao) {
    LAS unsigned* sc = (LAS unsigned*)lds;
    LAS unsigned short* sel = (LAS unsigned short*)(lds + 131072);
    const int tid = my_tid(), wid = __builtin_amdgcn_readfirstlane(tid >> 6), lane = tid & 63, r = lane & 31, h = lane >> 5;
    for (int g = my_bid(); g < NTOK / 4; g += gridDim.x) {
        const int tok0 = g * 4, b = tok0 >> 13, s0 = tok0 & (SEQ - 1);
        const int ntile = (s0 + 4 + 31) >> 5, nround = (ntile * 32 + 255) & ~255;
        {
            bf16x8 a[4]; float w[4][4];
            { const bf16_t* p = proj + (size_t)(tok0 + (r >> 3)) * AINP + 1536 + (r & 7) * 64 + 8 * h;
#pragma unroll
              for (int ks = 0; ks < 4; ++ks) a[ks] = *(const bf16x8*)(p + ks * 16); }
#pragma unroll
            for (int qq = 0; qq < 4; ++qq) { const u32x2 wv = *(const u32x2*)(proj + (size_t)(tok0 + qq) * AINP + 2112 + 4 * h);
                const float sc_ = 0.35355339059327373f * 0.125f; w[qq][0] = bflo(wv.x) * sc_; w[qq][1] = bfhi(wv.x) * sc_; w[qq][2] = bflo(wv.y) * sc_; w[qq][3] = bfhi(wv.y) * sc_; }
            for (int kt = wid; kt < ntile; kt += 8) {
                const bf16_t* kp = proj + (size_t)(b * SEQ + kt * 32 + r) * AINP + 2048 + 8 * h;
                bf16x8 bb[4];
#pragma unroll
                for (int ks = 0; ks < 4; ++ks) bb[ks] = *(const bf16x8*)(kp + ks * 16);
                f32x16 x;
#pragma unroll
                for (int i = 0; i < 16; ++i) x[i] = 0.f;
#pragma unroll
                for (int ks = 0; ks < 4; ++ks) x = MFMA32(a[ks], bb[ks], x);
                float s4[4];
#pragma unroll
                for (int qq = 0; qq < 4; ++qq) { float s = w[qq][0] * fmaxf(x[4 * qq], 0.f); s += w[qq][1] * fmaxf(x[4 * qq + 1], 0.f); s += w[qq][2] * fmaxf(x[4 * qq + 2], 0.f); s += w[qq][3] * fmaxf(x[4 * qq + 3], 0.f);
                    s += __shfl_xor(s, 32); s4[qq] = s; }
                const int key = kt * 32 + r;
#pragma unroll
                for (int e = 0; e < 2; ++e) { const int qq = 2 * h + e; const float vsel = e ? (h ? s4[3] : s4[1]) : (h ? s4[2] : s4[0]); const float v = vsel + 0.f;
                    unsigned u = __float_as_uint(v); u = (u >> 31) ? ~u : (u | 0x80000000u); if (key > s0 + qq) u = 0u; sc[qq * SEQ + key] = u; }
            }
            const int tl = nround - ntile * 32;
            for (int i = tid; i < 4 * tl; i += 512) { const int qq = i / tl, kk = ntile * 32 + (i - qq * tl); sc[qq * SEQ + kk] = 0u; }
        }
        __syncthreads();
        if (wid < 4) {
            const int qq = wid, n = s0 + qq + 1, tok = tok0 + qq;
            LAS unsigned* row = sc + qq * SEQ; LAS unsigned short* sl = sel + qq * 256;
            int nsel;
            if (n <= 256) { nsel = n;
#pragma unroll
                for (int i = 0; i < 4; ++i) { const int p = lane + 64 * i; sl[p] = (unsigned short)(p < n ? p : 0); } }
            else { nsel = 256;
                unsigned T = 0u;
                for (int bit = 31; bit >= 0; --bit) { const unsigned cand = T | (1u << bit); int cnt = 0;
                    for (int i = lane * 4; i < nround; i += 256) { const u32x4 v = *(const LAS u32x4*)(row + i);
                        cnt += __popcll(__ballot(v.x >= cand)) + __popcll(__ballot(v.y >= cand)) + __popcll(__ballot(v.z >= cand)) + __popcll(__ballot(v.w >= cand)); }
                    if (cnt >= 256) T = cand; }
                int cgt = 0;
                for (int i = lane * 4; i < nround; i += 256) { const u32x4 v = *(const LAS u32x4*)(row + i);
                    cgt += __popcll(__ballot(v.x > T)) + __popcll(__ballot(v.y > T)) + __popcll(__ballot(v.z > T)) + __popcll(__ballot(v.w > T)); }
                const int need = 256 - cgt; int base = 0, eqb = 0; const unsigned long long ltm = (1ull << lane) - 1ull;
                for (int i0 = 0; i0 < nround; i0 += 64) { const unsigned u = row[i0 + lane]; const bool gt = u > T, eq = u == T;
                    const unsigned long long me = __ballot(eq); const bool take = gt || (eq && (eqb + __popcll(me & ltm)) < need);
                    const unsigned long long mt = __ballot(take); if (take) sl[base + __popcll(mt & ltm)] = (unsigned short)(i0 + lane);
                    base += __popcll(mt); eqb += __popcll(me); }
            }
            LDS_WAIT();
            const int fr = lane & 15, fq = lane >> 4;
            bf16x8 qa, qb, qz;
            { const bf16_t* qp = proj + (size_t)tok * AINP + fr * 64 + fq * 8; qa = *(const bf16x8*)qp; qb = *(const bf16x8*)(qp + 32);
#pragma unroll
              for (int i = 0; i < 8; ++i) qz[i] = 0; }
            const int qg = fr >> 2;
#define QF(st) ((((st) >> 1) == qg) ? (((st) & 1) ? qb : qa) : qz)
            const bf16_t* kbase = proj + (size_t)(b * SEQ) * AINP + 1024 + fq * 8;
            const int ntl = (nsel + 15) >> 4;
            f32x4 sacc[16];
#pragma unroll
            for (int jt = 0; jt < 16; ++jt) {
                f32x4 acc = (f32x4){0.f, 0.f, 0.f, 0.f};
                if (jt < ntl) { const int kidx = sl[jt * 16 + fr]; const bf16_t* kr = kbase + (size_t)kidx * AINP;
#pragma unroll
                    for (int st = 0; st < 8; ++st) acc = MFMA16(*(const bf16x8*)(kr + st * 32), QF(st), acc); }
#pragma unroll
                for (int j = 0; j < 4; ++j) if (jt * 16 + 4 * fq + j >= nsel) acc[j] = -INFINITY;
                sacc[jt] = acc;
            }
            float mx = -INFINITY;
#pragma unroll
            for (int jt = 0; jt < 16; ++jt) mx = fmaxf(mx, fmaxf(fmaxf(sacc[jt][0], sacc[jt][1]), fmaxf(sacc[jt][2], sacc[jt][3])));
            mx = fmaxf(mx, __shfl_xor(mx, 16)); mx = fmaxf(mx, __shfl_xor(mx, 32));
            float sum = 0.f; bf16x8 pf[8];
#pragma unroll
            for (int s = 0; s < 8; ++s) { float p[8];
#pragma unroll
                for (int j = 0; j < 4; ++j) { p[j] = __builtin_amdgcn_exp2f((sacc[2 * s][j] - mx) * (0.125f * 1.4426950408889634f)); p[4 + j] = __builtin_amdgcn_exp2f((sacc[2 * s + 1][j] - mx) * (0.125f * 1.4426950408889634f)); }
                u32x4 pw; pw.x = pk2(p[0], p[1]); pw.y = pk2(p[2], p[3]); pw.z = pk2(p[4], p[5]); pw.w = pk2(p[6], p[7]);
                sum += ((p[0] + p[1]) + (p[2] + p[3])) + ((p[4] + p[5]) + (p[6] + p[7]));
                pf[s] = __builtin_bit_cast(bf16x8, pw); }
            sum += __shfl_xor(sum, 16); sum += __shfl_xor(sum, 32);
            const float inv = 1.f / sum;
            f32x4 oacc[16];
#pragma unroll
            for (int dt = 0; dt < 16; ++dt) oacc[dt] = (f32x4){0.f, 0.f, 0.f, 0.f};
            LAS unsigned char* vimg = (LAS unsigned char*)row;
            const bf16_t* vbase = proj + (size_t)(b * SEQ) * AINP + 1280 + (lane & 31) * 8;
            const unsigned traddr = (unsigned)(size_t)vimg + (unsigned)((8 * fq + ((lane >> 2) & 3)) * VROW + 8 * (lane & 3));
#pragma unroll
            for (int s = 0; s < 8; ++s) {
                if (2 * s < ntl) {
#pragma unroll
                    for (int u = 0; u < 16; ++u) { const int rho = u * 2 + (lane >> 5); const int fqr = rho >> 3, j = rho & 7;
                        const int pos = (2 * s + (j >> 2)) * 16 + 4 * fqr + (j & 3); const int kidx = sl[pos];
                        const u32x4 val = *(const u32x4*)(vbase + (size_t)kidx * AINP);
                        *(LAS u32x4*)(vimg + rho * VROW + (lane & 31) * 16) = val; }
                    LDS_WAIT();
                    s16x4 t8[8];
#define PV4(T0) tr_read8<(T0) * 32>(traddr, t8); \
                    oacc[T0] = MFMA16(pf[s], __builtin_shufflevector(t8[0], t8[1], 0, 1, 2, 3, 4, 5, 6, 7), oacc[T0]); \
                    oacc[T0 + 1] = MFMA16(pf[s], __builtin_shufflevector(t8[2], t8[3], 0, 1, 2, 3, 4, 5, 6, 7), oacc[T0 + 1]); \
                    oacc[T0 + 2] = MFMA16(pf[s], __builtin_shufflevector(t8[4], t8[5], 0, 1, 2, 3, 4, 5, 6, 7), oacc[T0 + 2]); \
                    oacc[T0 + 3] = MFMA16(pf[s], __builtin_shufflevector(t8[6], t8[7], 0, 1, 2, 3, 4, 5, 6, 7), oacc[T0 + 3]);
                    PV4(0) PV4(4) PV4(8) PV4(12)
#undef PV4
                }
            }
            float ivj[4];
#pragma unroll
            for (int j = 0; j < 4; ++j) ivj[j] = __shfl(inv, 4 * fq + j);
#pragma unroll
            for (int dt = 0; dt < 16; ++dt) if (fq == (dt >> 2)) {
#pragma unroll
                for (int j = 0; j < 4; ++j) ao[(size_t)tok * DM + (4 * fq + j) * 64 + (dt & 3) * 16 + fr] = (bf16_t)f2bf(oacc[dt][j] * ivj[j]); }
        }
        __syncthreads();
    }
}
constexpr int G_ALOW = 0, G_BC = 4096, G_TOT = 36864, G_KST = 38912, G_VT = 57344, G_QI = 94208, G_KI = 111616, G_AT = 129024, G_PART = 138240;
DI void gla_gate(LAS unsigned char* lds, const bf16_t* proj, const float* w_a2, const float* b_a, int t0, int hh, int tid) {
    LAS float* alow = (LAS float*)(lds + G_ALOW); LAS float* bc = (LAS float*)(lds + G_BC); LAS float* tot = (LAS float*)(lds + G_TOT);
    for (int i = tid; i < 1024; i += 512) alow[i] = bf1(proj[(size_t)(t0 + (i >> 4)) * BINP + 3072 + (i & 15)]);
    __syncthreads();
    const int d = tid & 127, jg = tid >> 7;
    float wv[16];
#pragma unroll
    for (int rr = 0; rr < 16; ++rr) wv[rr] = w_a2[rr * 512 + hh * 128 + d];
    const float bias = b_a[hh * 128 + d];
    float gl[16]; float run = 0.f;
#pragma unroll
    for (int jj = 0; jj < 16; ++jj) { const LAS f32x4* ap = (const LAS f32x4*)(alow + (jg * 16 + jj) * 16); float z = bias;
#pragma unroll
        for (int q4 = 0; q4 < 4; ++q4) { const f32x4 av = ap[q4]; z += av.x * wv[4 * q4] + av.y * wv[4 * q4 + 1] + av.z * wv[4 * q4 + 2] + av.w * wv[4 * q4 + 3]; }
        const float ls = fminf(z, 0.f) - __logf(1.f + __expf(-fabsf(z)));
        run += ls * 0.0625f; gl[jj] = run; }
    tot[jg * 128 + d] = run;
    __syncthreads();
    float off = 0.f;
#pragma unroll
    for (int q = 0; q < 3; ++q) if (q < jg) off += tot[q * 128 + d];
#pragma unroll
    for (int jj = 0; jj < 16; ++jj) bc[(jg * 16 + jj) * 128 + d] = off + gl[jj];
    __syncthreads();
}
DI void gla_load_vt(LAS unsigned char* lds, const bf16_t* proj, int t0, int hh, int tid) {
    LAS bf16_t* vt = (LAS bf16_t*)(lds + G_VT);
    for (int it = tid; it < 2048; it += 512) { const int j = it >> 5, e0 = (it & 31) * 8;
        const u32x4 vv = *(const u32x4*)(proj + (size_t)(t0 + j) * BINP + 1024 + hh * 256 + e0);
        vt[(e0 + 0) * 72 + j] = (bf16_t)(vv.x & 0xffffu); vt[(e0 + 1) * 72 + j] = (bf16_t)(vv.x >> 16); vt[(e0 + 2) * 72 + j] = (bf16_t)(vv.y & 0xffffu); vt[(e0 + 3) * 72 + j] = (bf16_t)(vv.y >> 16);
        vt[(e0 + 4) * 72 + j] = (bf16_t)(vv.z & 0xffffu); vt[(e0 + 5) * 72 + j] = (bf16_t)(vv.z >> 16); vt[(e0 + 6) * 72 + j] = (bf16_t)(vv.w & 0xffffu); vt[(e0 + 7) * 72 + j] = (bf16_t)(vv.w >> 16); }
}
DI void gla_g1(LAS unsigned char* lds, const bf16_t* proj, const float* w_a2, const float* b_a, bf16_t* DS, float* DEC) {
    const int tid = my_tid(), wid = tid >> 6, lane = tid & 63, r = lane & 31, h = lane >> 5;
    LAS float* bc = (LAS float*)(lds + G_BC); LAS bf16_t* kst = (LAS bf16_t*)(lds + G_KST); LAS bf16_t* vt = (LAS bf16_t*)(lds + G_VT);
    for (int unit = my_bid_v(); unit < 2048; unit += gridDim.x) {
        const int b = unit >> 9, hh = (unit >> 7) & 3, c = unit & 127, t0 = b * SEQ + c * 64;
        gla_gate(lds, proj, w_a2, b_a, t0, hh, tid);
        for (int it = tid; it < 1024; it += 512) { const int j = it >> 4, d0 = (it & 15) * 8;
            const u32x4 kv = *(const u32x4*)(proj + (size_t)(t0 + j) * BINP + 512 + hh * 128 + d0);
            const unsigned kw[4] = {kv.x, kv.y, kv.z, kv.w};
#pragma unroll
            for (int i = 0; i < 8; ++i) { const int d = d0 + i; const float kf = (i & 1) ? bfhi(kw[i >> 1]) : bflo(kw[i >> 1]);
                kst[d * 72 + j] = (bf16_t)f2bf(kf * __expf(bc[63 * 128 + d] - bc[j * 128 + d])); } }
        gla_load_vt(lds, proj, t0, hh, tid);
        if (tid < 128) DEC[(size_t)unit * 128 + tid] = __expf(bc[63 * 128 + tid]);
        __syncthreads();
        bf16x8 a[4];
#pragma unroll
        for (int ks = 0; ks < 4; ++ks) a[ks] = *(const LAS bf16x8*)(vt + (32 * wid + r) * 72 + ks * 16 + 8 * h);
#pragma unroll
        for (int nt = 0; nt < 4; ++nt) { f32x16 x;
#pragma unroll
            for (int i = 0; i < 16; ++i) x[i] = 0.f;
#pragma unroll
            for (int ks = 0; ks < 4; ++ks) x = MFMA32(a[ks], *(const LAS bf16x8*)(kst + (nt * 32 + r) * 72 + ks * 16 + 8 * h), x);
#pragma unroll
            for (int i = 0; i < 16; ++i) DS[((size_t)unit * 256 + 32 * wid + crow(i, h)) * 128 + nt * 32 + r] = (bf16_t)f2bf(x[i]); }
        __syncthreads();
    }
}
DI void gla_g2(bf16_t* DS, const float* DEC, int gtid, int gt) {
    for (int idx = gtid; idx < 131072; idx += gt) {
        const int bh = idx >> 13, e = (idx >> 5) & 255, d0 = (idx & 31) * 4;
        bf16_t* p = DS + ((size_t)(bh * 128) * 256 + e) * 128 + d0; const float* dp = DEC + (size_t)bh * 128 * 128 + d0;
        float S0 = 0.f, S1 = 0.f, S2 = 0.f, S3 = 0.f;
#pragma unroll 8
        for (int c = 0; c < 128; ++c) { const u32x2 v = *(const u32x2*)(p + (size_t)c * 32768); const f32x4 dc = *(const f32x4*)(dp + c * 128);
            u32x2 o; o.x = pk2(S0, S1); o.y = pk2(S2, S3); *(u32x2*)(p + (size_t)c * 32768) = o;
            S0 = dc.x * S0 + bflo(v.x); S1 = dc.y * S1 + bfhi(v.x); S2 = dc.z * S2 + bflo(v.y); S3 = dc.w * S3 + bfhi(v.y); }
    }
}
DI void gla_g3(LAS unsigned char* lds, bf16_t* proj, const float* w_a2, const float* b_a, const float* g_norm, const bf16_t* DS) {
    const int tid = my_tid(), wid = tid >> 6, lane = tid & 63, r = lane & 31, h = lane >> 5;
    LAS float* bc = (LAS float*)(lds + G_BC); LAS bf16_t* vt = (LAS bf16_t*)(lds + G_VT); LAS bf16_t* qi = (LAS bf16_t*)(lds + G_QI); LAS bf16_t* ki = (LAS bf16_t*)(lds + G_KI);
    LAS bf16_t* at = (LAS bf16_t*)(lds + G_AT); LAS float* part = (LAS float*)(lds + G_PART);
    for (int unit = my_bid_v(); unit < 2048; unit += gridDim.x) {
        const int b = unit >> 9, hh = (unit >> 7) & 3, c = unit & 127, t0 = b * SEQ + c * 64;
        gla_gate(lds, proj, w_a2, b_a, t0, hh, tid);
        for (int it = tid; it < 1024; it += 512) { const int j = it >> 4, d0 = (it & 15) * 8;
            const bf16_t* rp = proj + (size_t)(t0 + j) * BINP + hh * 128 + d0;
            const u32x4 qv = *(const u32x4*)rp, kv = *(const u32x4*)(rp + 512);
            const f32x4 b0 = *(const LAS f32x4*)(bc + j * 128 + d0), b1 = *(const LAS f32x4*)(bc + j * 128 + d0 + 4);
            const float bv[8] = {b0.x, b0.y, b0.z, b0.w, b1.x, b1.y, b1.z, b1.w};
            const unsigned qw[4] = {qv.x, qv.y, qv.z, qv.w}, kw[4] = {kv.x, kv.y, kv.z, kv.w};
            float qo[8], ko[8];
#pragma unroll
            for (int i = 0; i < 8; ++i) { const float qf = (i & 1) ? bfhi(qw[i >> 1]) : bflo(qw[i >> 1]), kf = (i & 1) ? bfhi(kw[i >> 1]) : bflo(kw[i >> 1]);
                qo[i] = qf * 0.08838834764831845f * __expf(bv[i]); ko[i] = kf * __expf(-bv[i]); }
            u32x4 qp, kp; qp.x = pk2(qo[0], qo[1]); qp.y = pk2(qo[2], qo[3]); qp.z = pk2(qo[4], qo[5]); qp.w = pk2(qo[6], qo[7]);
            kp.x = pk2(ko[0], ko[1]); kp.y = pk2(ko[2], ko[3]); kp.z = pk2(ko[4], ko[5]); kp.w = pk2(ko[6], ko[7]);
            *(LAS u32x4*)(qi + j * 136 + d0) = qp; *(LAS u32x4*)(ki + j * 136 + d0) = kp; }
        gla_load_vt(lds, proj, t0, hh, tid);
        __syncthreads();
        if (wid < 4) { const int it_ = wid >> 1, jt = wid & 1; f32x16 x;
#pragma unroll
            for (int i = 0; i < 16; ++i) x[i] = 0.f;
#pragma unroll
            for (int ks = 0; ks < 8; ++ks) x = MFMA32(*(const LAS bf16x8*)(qi + (it_ * 32 + r) * 136 + ks * 16 + 8 * h), *(const LAS bf16x8*)(ki + (jt * 32 + r) * 136 + ks * 16 + 8 * h), x);
#pragma unroll
            for (int i = 0; i < 16; ++i) { const int ii = it_ * 32 + crow(i, h), jj = jt * 32 + r; at[ii * 72 + jj] = (bf16_t)((jj <= ii) ? f2bf(x[i]) : 0u); } }
        __syncthreads();
        f32x16 o0, o1;
#pragma unroll
        for (int i = 0; i < 16; ++i) { o0[i] = 0.f; o1[i] = 0.f; }
#pragma unroll
        for (int ks = 0; ks < 4; ++ks) { const bf16x8 a = *(const LAS bf16x8*)(vt + (32 * wid + r) * 72 + ks * 16 + 8 * h);
            o0 = MFMA32(a, *(const LAS bf16x8*)(at + r * 72 + ks * 16 + 8 * h), o0); o1 = MFMA32(a, *(const LAS bf16x8*)(at + (32 + r) * 72 + ks * 16 + 8 * h), o1); }
        { const bf16_t* sp = DS + ((size_t)unit * 256 + 32 * wid + r) * 128 + 8 * h;
#pragma unroll
          for (int ks = 0; ks < 8; ++ks) { const bf16x8 a = *(const bf16x8*)(sp + ks * 16);
            o0 = MFMA32(a, *(const LAS bf16x8*)(qi + r * 136 + ks * 16 + 8 * h), o0); o1 = MFMA32(a, *(const LAS bf16x8*)(qi + (32 + r) * 136 + ks * 16 + 8 * h), o1); } }
        float ss0 = 0.f, ss1 = 0.f;
#pragma unroll
        for (int i = 0; i < 16; ++i) { ss0 += o0[i] * o0[i]; ss1 += o1[i] * o1[i]; }
        ss0 += __shfl_xor(ss0, 32); ss1 += __shfl_xor(ss1, 32);
        if (h == 0) { part[wid * 64 + r] = ss0; part[wid * 64 + 32 + r] = ss1; }
        __syncthreads();
        float t0s = 0.f, t1s = 0.f;
#pragma unroll
        for (int w = 0; w < 8; ++w) { t0s += part[w * 64 + r]; t1s += part[w * 64 + 32 + r]; }
        const float rs0 = 1.f / sqrtf(t0s * (1.f / 256.f) + 1e-6f), rs1 = 1.f / sqrtf(t1s * (1.f / 256.f) + 1e-6f);
#pragma unroll
        for (int gi = 0; gi < 4; ++gi) { const int e0 = 32 * wid + 8 * gi + 4 * h; const f32x4 gn = *(const f32x4*)(g_norm + e0);
#pragma unroll
            for (int nt = 0; nt < 2; ++nt) { bf16_t* yp = proj + (size_t)(t0 + nt * 32 + r) * BINP + 2048 + hh * 256 + e0; const u32x2 rv = *(const u32x2*)yp;
                const float rs = nt ? rs1 : rs0; const float rr[4] = {bflo(rv.x), bfhi(rv.x), bflo(rv.y), bfhi(rv.y)}; const float gv[4] = {gn.x, gn.y, gn.z, gn.w}; float y[4];
#pragma unroll
                for (int jj = 0; jj < 4; ++jj) { const float o = nt ? o1[4 * gi + jj] : o0[4 * gi + jj]; y[jj] = o * rs * gv[jj] * (rr[jj] / (1.f + __expf(-rr[jj]))); }
                u32x2 w2; w2.x = pk2(y[0], y[1]); w2.y = pk2(y[2], y[3]); *(u32x2*)yp = w2; } }
        __syncthreads();
    }
}
struct Args { const float* in[15]; float* out; unsigned char* ws; };
constexpr int CTX_OFF = LDS_BYTES - 256;
DI unsigned long long ctx_ld(LAS unsigned char* lds, int i) {
    volatile LAS unsigned* p = (volatile LAS unsigned*)(lds + CTX_OFF) + 2 * i; unsigned lo = p[0], hi = p[1];
    lo = __builtin_amdgcn_readfirstlane(lo); hi = __builtin_amdgcn_readfirstlane(hi); return ((unsigned long long)hi << 32) | lo;
}
#define CPTR(T, i) ((T)ctx_ld(lds, (i)))
#define GSYNC() cg::this_grid().sync()
__global__ void __launch_bounds__(512, 2) fwd(Args a) {
    extern __shared__ __attribute__((aligned(16))) unsigned char lds_raw[];
    LAS unsigned char* lds = (LAS unsigned char*)(unsigned)0u;
    if ((unsigned)(size_t)(LAS unsigned char*)lds_raw != 0u) return;
    if (threadIdx.x == 0) { LAS unsigned long long* c = (LAS unsigned long long*)(lds + CTX_OFF);
#pragma unroll
        for (int i = 0; i < 15; ++i) c[i] = (unsigned long long)a.in[i];
        c[15] = (unsigned long long)a.out; c[16] = (unsigned long long)a.ws; }
    __syncthreads();
    {
#ifndef NO_P0
            const int tid = my_tid(), lane = tid & 63, wid = __builtin_amdgcn_readfirstlane(tid >> 6), bid = my_bid(), G = gridDim.x;
            const int gw = bid * 8 + wid, ngw = G * 8, gtid = bid * 512 + tid, gt = G * 512;
            unsigned char* ws = CPTR(unsigned char*, 16);
            LAS float* scr = (LAS float*)(lds + wid * 16640);
            for (int j = 0; j < 2; ++j) {
                transpose_matrix(CPTR(const float*, 2) + (size_t)j * 1024 * AIN, 1024, AIN, AINP, (bf16_t*)(ws + OFF_AIN + j * SZ_AIN), scr, gw, ngw, lane);
                transpose_matrix(CPTR(const float*, 3) + (size_t)j * 1024 * 1024, 1024, 1024, 1024, (bf16_t*)(ws + OFF_AO + j * SZ_SQ), scr, gw, ngw, lane);
                transpose_matrix(CPTR(const float*, 4) + (size_t)j * 1024 * BIN, 1024, BIN, BINP, (bf16_t*)(ws + OFF_BIN + j * SZ_BIN), scr, gw, ngw, lane);
                transpose_matrix(CPTR(const float*, 8) + (size_t)j * 1024 * 1024, 1024, 1024, 1024, (bf16_t*)(ws + OFF_BO + j * SZ_SQ), scr, gw, ngw, lane); }
            for (int i = 0; i < 4; ++i) {
                transpose_matrix(CPTR(const float*, 11) + (size_t)i * 1024 * FF, 1024, FF, FF, (bf16_t*)(ws + OFF_UP + i * SZ_FF), scr, gw, ngw, lane);
                transpose_matrix(CPTR(const float*, 12) + (size_t)i * FF * 1024, FF, 1024, 1024, (bf16_t*)(ws + OFF_DN + i * SZ_FF), scr, gw, ngw, lane); }
            rot_table(CPTR(const int*, 1), (float*)(ws + WS_ROT), gtid, gt);
            const float* x = CPTR(const float*, 0); bf16_t* hb = (bf16_t*)(ws + WS_HB);
            for (size_t i = gtid; i < (size_t)NTOK * DM / 8; i += gt) { const f32x4 v0 = ((const f32x4*)x)[2 * i], v1 = ((const f32x4*)x)[2 * i + 1];
                u32x4 w; w.x = pk2(v0.x, v0.y); w.y = pk2(v0.z, v0.w); w.z = pk2(v1.x, v1.y); w.w = pk2(v1.z, v1.w); ((u32x4*)hb)[i] = w; }
#endif
    }
    GSYNC();
    enum { K_P0, K_GB, K_ROT, K_DSA, K_G1, K_G2, K_G3, K_GR, K_LN };
    int s = 0, k = 0;
    for (;;) {
        int kind, cnt;
        if (s & 1) { cnt = 3; kind = k == 0 ? K_GB : k == 1 ? K_GR : K_LN; }
        else if ((s & 2) == 0) { cnt = 5; kind = k == 0 ? K_GB : k == 1 ? K_ROT : k == 2 ? K_DSA : k == 3 ? K_GR : K_LN; }
        else { cnt = 6; kind = k == 0 ? K_GB : k == 1 ? K_G1 : k == 2 ? K_G2 : k == 3 ? K_G3 : k == 4 ? K_GR : K_LN; }
        if (kind == K_GB) {
            const int L = s >> 1, sub = s & 1, mix = L & 1, j = L >> 1;
            unsigned char* ws = CPTR(unsigned char*, 16);
            pg8::Gemm g; pg8::EpiBf16R E;
            g.A = (const bf16_t*)(ws + WS_HB); g.M = NTOK; g.K = 1024; g.lda = 1024; E.O = (bf16_t*)(ws + WS_R);
            if (sub == 0) { g.Bt = mix ? (const bf16_t*)(ws + OFF_BIN + j * SZ_BIN) : (const bf16_t*)(ws + OFF_AIN + j * SZ_AIN); g.N = mix ? BINP : AINP; E.act = 0; }
            else { g.Bt = (const bf16_t*)(ws + OFF_UP + L * SZ_FF); g.N = FF; E.act = 2; }
            E.ldc = g.N;
            pg8::StaticOrder S; S.init(NTOK, g.N, gridDim.x, (int)blockIdx.x);
#ifndef NO_GEMM
            pg8::gemm_phase<pg8::EpiBf16R, pg8::StaticOrder, true, true>(lds, g, S, E);
#endif
        } else if (kind == K_ROT) {
#ifndef NO_ROT
            const int tid = my_tid(), bid = my_bid(); unsigned char* ws = CPTR(unsigned char*, 16);
            rotary_phase((bf16_t*)(ws + WS_R), (const float*)(ws + WS_ROT), bid * 512 + tid, (int)gridDim.x * 512);
#endif
        } else if (kind == K_DSA) {
#ifndef NO_DSA
            unsigned char* ws = CPTR(unsigned char*, 16); dsa_phase(lds, (const bf16_t*)(ws + WS_R), (bf16_t*)(ws + WS_AO));
#endif
        } else if (kind == K_G1) {
#ifndef NO_G1
            const int j = s >> 2; unsigned char* ws = CPTR(unsigned char*, 16);
            gla_g1(lds, (const bf16_t*)(ws + WS_R), CPTR(const float*, 5) + (size_t)j * 16 * 512, CPTR(const float*, 6) + j * 512, (bf16_t*)(ws + WS_DS), (float*)(ws + WS_DEC));
#endif
        } else if (kind == K_G2) {
#ifndef NO_G2
            const int tid = my_tid(), bid = my_bid(); unsigned char* ws = CPTR(unsigned char*, 16);
            gla_g2((bf16_t*)(ws + WS_DS), (const float*)(ws + WS_DEC), bid * 512 + tid, (int)gridDim.x * 512);
#endif
        } else if (kind == K_G3) {
#ifndef NO_G3
            const int j = s >> 2; unsigned char* ws = CPTR(unsigned char*, 16);
            gla_g3(lds, (bf16_t*)(ws + WS_R), CPTR(const float*, 5) + (size_t)j * 16 * 512, CPTR(const float*, 6) + j * 512, CPTR(const float*, 7) + j * 256, (const bf16_t*)(ws + WS_DS));
#endif
        } else if (kind == K_GR) {
            const int L = s >> 1, sub = s & 1, mix = L & 1, j = L >> 1;
            unsigned char* ws = CPTR(unsigned char*, 16); float* out = CPTR(float*, 15);
            pg8::Gemm g; pg8::EpiResid E;
            g.M = NTOK; g.N = 1024;
            if (sub == 0) { g.K = 1024; E.base = (L == 0) ? CPTR(const float*, 0) : out;
                if (mix) { g.A = (const bf16_t*)(ws + WS_R) + 2048; g.lda = BINP; g.Bt = (const bf16_t*)(ws + OFF_BO + j * SZ_SQ); }
                else { g.A = (const bf16_t*)(ws + WS_AO); g.lda = 1024; g.Bt = (const bf16_t*)(ws + OFF_AO + j * SZ_SQ); } }
            else { g.A = (const bf16_t*)(ws + WS_R); g.lda = FF; g.K = FF; g.Bt = (const bf16_t*)(ws + OFF_DN + L * SZ_FF); E.base = out; }
            E.out = out; E.ldc = 1024; E.alpha = DN_ALPHA;
            pg8::StaticOrder S; S.init(NTOK, 1024, gridDim.x, (int)blockIdx.x);
#ifndef NO_GEMM
            pg8::gemm_phase<pg8::EpiResid, pg8::StaticOrder, true, true>(lds, g, S, E);
#endif
        } else {
#ifndef NO_LN
            const int tid = my_tid(), lane = tid & 63, wid = __builtin_amdgcn_readfirstlane(tid >> 6), bid = my_bid();
            const int L = s >> 1, sub = s & 1; unsigned char* ws = CPTR(unsigned char*, 16);
            ln_phase(CPTR(float*, 15), (bf16_t*)(ws + WS_HB), CPTR(const float*, sub ? 13 : 9) + L * 1024, CPTR(const float*, sub ? 14 : 10) + L * 1024, bid * 8 + wid, (int)gridDim.x * 8, lane);
#endif
        }
        if (s == 7 && k == cnt - 1) break;
        GSYNC();
        if (++k == cnt) { k = 0; ++s; }
    }
}
extern "C" void kernel_launch(void* const* d_in, const int* in_sizes, int n_in, void* d_out, int out_size, void* d_ws, size_t ws_size, hipStream_t stream) {
    static int grid = 0;
    if (grid == 0) {
        if (n_in != 15 || out_size != NTOK * DM || ws_size < WS_END) { fprintf(stderr, "kernel_launch: unexpected shapes (n_in %d out %d ws %zu)\n", n_in, out_size, ws_size); grid = -1; return; }
        int dev = 0, cus = 0, per_cu = 0;
        (void)hipGetDevice(&dev); (void)hipDeviceGetAttribute(&cus, hipDeviceAttributeMultiprocessorCount, dev);
        if (hipFuncSetAttribute((const void*)fwd, hipFuncAttributeMaxDynamicSharedMemorySize, LDS_BYTES) != hipSuccess) { fprintf(stderr, "kernel_launch: hipFuncSetAttribute failed\n"); grid = -1; return; }
        if (hipOccupancyMaxActiveBlocksPerMultiprocessor(&per_cu, (const void*)fwd, 512, LDS_BYTES) != hipSuccess || per_cu < 1) { fprintf(stderr, "kernel_launch: occupancy query gave %d\n", per_cu); per_cu = 1; }
        (void)hipGetLastError();
        grid = cus * per_cu;
    }
    if (grid < 0) return;
    Args a{};
    for (int i = 0; i < 15; ++i) a.in[i] = (const float*)d_in[i];
    a.out = (float*)d_out; a.ws = (unsigned char*)d_ws;
    void* args[] = {&a};
    hipError_t e = hipLaunchCooperativeKernel((const void*)fwd, dim3(grid), dim3(512), args, LDS_BYTES, stream);
    if (e != hipSuccess) fprintf(stderr, "kernel_launch: cooperative launch failed: %s (grid %d)\n", hipGetErrorString(e), grid);
}
```

```cpp
#include <hip/hip_runtime.h>
#include <hip/hip_cooperative_groups.h>
#include <cstdio>
#include <cstdint>
namespace cg = cooperative_groups;
namespace pg8 {
#define PG8_LAS __attribute__((address_space(3)))
typedef unsigned short bf16_t;
typedef short bf16x8 __attribute__((ext_vector_type(8)));
typedef float f32x4 __attribute__((ext_vector_type(4)));
typedef unsigned u32x4 __attribute__((ext_vector_type(4)));
constexpr int BM = 256, BK = 64, HALF = 128, HTB = HALF * BK * 2  , STAGE_BYTES = 8 * HTB, NXCD = 8, WGM = 8;

__host__ __device__ __forceinline__ int lds_byte(int r, int c) { const int st = (r >> 4) * 2 + (c >> 5), rr = r & 15, cc = c & 31, ob = rr * 64 + cc * 2; return st * 1024 + (ob ^ (((ob >> 9) & 1) << 5)); }
__host__ __device__ __forceinline__ void stage_rc(int b, int& R, int& C) { const int st = b / 1024, sb = b % 1024, swz = sb ^ (((sb >> 9) & 1) << 5); R = (st >> 1) * 16 + swz / 64; C = (st & 1) * 32 + (swz % 64) / 2; }
__host__ __device__ __forceinline__ int perm32(int rho) { const int n = rho >> 4, i = rho & 15; return 8 * (i >> 2) + 4 * n + (i & 3); }

struct Unit { int pm, pn; };
struct Gemm { const bf16_t* A; const bf16_t* Bt; int M, N, K, lda; };

struct StaticOrder {
    int nM, nN, nwg, G, c;
    __host__ __device__ void init(int M, int N, int G_, int c_) { nM = M / BM; nN = N / BM; nwg = nM * nN; G = G_; c = c_; }
    __host__ __device__ bool next(int i, Unit& u) const {
        const long L = (long)i * G + c; if (L >= nwg) return false;
        int wgid = (int)L; { const int q = nwg / NXCD, r = nwg % NXCD, xcd = wgid % NXCD, off = wgid / NXCD; wgid = (xcd < r ? xcd * (q + 1) : r * (q + 1) + (xcd - r) * q) + off; }
        const int nig = WGM * nN, gid = wgid / nig, fm = gid * WGM, gsz = (nM - fm) < WGM ? (nM - fm) : WGM;
        u.pm = fm + ((wgid % nig) % gsz); u.pn = (wgid % nig) / gsz; return true;
    }
    __device__ __forceinline__ void a_ready(const Unit&) const {}
    __device__ __forceinline__ void done(const Unit&) const {}
};
__device__ __forceinline__ unsigned cvt_pk_bf16(float lo, float hi) { unsigned r; asm volatile("v_cvt_pk_bf16_f32 %0, %1, %2" : "=v"(r) : "v"(lo), "v"(hi)); return r; }
typedef float f32x2 __attribute__((ext_vector_type(2)));
struct EpiBf16R {
    static constexpr bool PERM = true, AFTER_DRAIN = false;
    bf16_t* O; int ldc; int act;
    __device__ __forceinline__ void operator()(const f32x4 (&acc)[2][2][4][2], const Unit& u, int wr, int wc, int fr, int fq) const {
        const int row0 = u.pm * BM + wr * 64 + fr; const int col0 = u.pn * BM + wc * 32 + 8 * fq;
        const f32x4 z4 = (f32x4){0.f, 0.f, 0.f, 0.f};
#pragma unroll
        for (int ai = 0; ai < 2; ++ai)
#pragma unroll
            for (int m = 0; m < 4; ++m) { bf16_t* rowp = O + (size_t)(row0 + ai * HALF + m * 16) * ldc + col0;
#pragma unroll
                for (int bj = 0; bj < 2; ++bj) { f32x4 v0 = acc[ai][bj][m][0], v1 = acc[ai][bj][m][1];
                    if (act) { v0 = __builtin_elementwise_max(v0, z4); v1 = __builtin_elementwise_max(v1, z4); v0 = v0 * v0; v1 = v1 * v1; }
                    u32x4 w; w.x = cvt_pk_bf16(v0[0], v0[1]); w.y = cvt_pk_bf16(v0[2], v0[3]); w.z = cvt_pk_bf16(v1[0], v1[1]); w.w = cvt_pk_bf16(v1[2], v1[3]);
                    *(u32x4*)(rowp + bj * HALF) = w; } }
    }
};
struct EpiResid {
    static constexpr bool PERM = false, AFTER_DRAIN = false;
    const float* base; float* out; int ldc; float alpha;
    __device__ __forceinline__ void operator()(const f32x4 (&acc)[2][2][4][2], const Unit& u, int wr, int wc, int fr, int fq) const {
        const int col0 = u.pn * BM + wc * 32 + 4 * fq;
#pragma unroll
        for (int ai = 0; ai < 2; ++ai)
#pragma unroll
            for (int m = 0; m < 4; ++m) { const size_t off = (size_t)(u.pm * BM + ai * HALF + wr * 64 + m * 16 + fr) * ldc + col0;
#pragma unroll
                for (int bj = 0; bj < 2; ++bj)
#pragma unroll
                    for (int n = 0; n < 2; ++n) { const size_t p = off + bj * HALF + n * 16; const f32x4 bs = *(const f32x4*)(base + p);
                        *(f32x4*)(out + p) = bs * alpha + acc[ai][bj][m][n]; }
                asm volatile("" ::: "memory"); }
    }
};
template <class Epi, class Sched, bool ALIGN_EPI = false, bool SP2 = false>
__device__ __forceinline__ void gemm_phase(PG8_LAS unsigned char* lds, const Gemm g, const Sched& S, const Epi& E) {
    int tid = threadIdx.x; asm volatile("" : "+v"(tid)); const int wid = __builtin_amdgcn_readfirstlane(tid >> 6), lane = tid & 63, wr = wid >> 2, wc = wid & 3, fr = lane & 15, fq = lane >> 4;
    const int K = g.K, nt = K / BK;
    unsigned voffA[2], voffB[2];
#pragma unroll
    for (int i = 0; i < 2; ++i) { int R, C; stage_rc(tid * 16 + i * 8192, R, C); const int Rb = Epi::PERM ? ((R & ~31) + perm32(R & 31)) : R;
        voffA[i] = (unsigned)(R * g.lda + C) * 2u; voffB[i] = (unsigned)(Rb * K + C) * 2u; }
    const size_t kstep = (size_t)(BK * 2);
    const size_t hstep = (size_t)HALF * K * 2; const size_t hstepA = (size_t)HALF * g.lda * 2;
    const size_t tstep = 2 * hstep; const size_t tstepA = 2 * hstepA;
    const unsigned ldsw = (unsigned)wid * 1024u;
    const int aoff = lds_byte(wr * 64 + fr, fq * 8), boff = lds_byte(wc * 32 + fr, fq * 8);
#define PG8_SA(b, h) (((b) * 2 + (h)) * HTB)
#define PG8_SB(b, h) ((4 + (b) * 2 + (h)) * HTB)
#define PG8_STAGE(bufoff, gbase, voff) do { _Pragma("unroll") for (int _i = 0; _i < 2; ++_i) \
        __builtin_amdgcn_global_load_lds((const unsigned*)((const char*)(gbase) + (voff)[_i]), (PG8_LAS unsigned*)(lds + (bufoff) + ldsw + _i * 8192), 16, 0, 0); } while (0)
#define PG8_LDA(dst, b, h) do { _Pragma("unroll") for (int m = 0; m < 4; ++m) _Pragma("unroll") for (int k = 0; k < 2; ++k) dst[m][k] = *(const PG8_LAS bf16x8*)(lds + PG8_SA(b, h) + aoff + m * 2048 + k * 1024); } while (0)
#define PG8_LDB(dst, b, h) do { _Pragma("unroll") for (int n = 0; n < 2; ++n) _Pragma("unroll") for (int k = 0; k < 2; ++k) dst[n][k] = *(const PG8_LAS bf16x8*)(lds + PG8_SB(b, h) + boff + n * 2048 + k * 1024); } while (0)
#define PG8_MMA(ai, bj, At, Bt) do { __builtin_amdgcn_s_setprio(1); _Pragma("unroll") for (int m = 0; m < 4; ++m) _Pragma("unroll") for (int n = 0; n < 2; ++n) _Pragma("unroll") for (int k = 0; k < 2; ++k) \
        acc[ai][bj][m][n] = __builtin_amdgcn_mfma_f32_16x16x32_bf16(Bt[n][k], At[m][k], acc[ai][bj][m][n], 0, 0, 0); __builtin_amdgcn_s_setprio(0); } while (0)
#define PG8_WAIT_V(n) asm volatile("s_waitcnt vmcnt(" #n ")" ::: "memory")
#define PG8_WAIT_L(n) asm volatile("s_waitcnt lgkmcnt(" #n ")" ::: "memory")
#define PG8_BAR __builtin_amdgcn_s_barrier()
#define PG8_SCHED __builtin_amdgcn_sched_barrier(0)
    Unit cur, nxt; int ui = 0;
    if (!S.next(0, cur)) return;
    f32x4 acc[2][2][4][2];
#pragma unroll
    for (int a = 0; a < 2; ++a)
#pragma unroll
        for (int b = 0; b < 2; ++b)
#pragma unroll
            for (int m = 0; m < 4; ++m)
#pragma unroll
                for (int n = 0; n < 2; ++n) acc[a][b][m][n] = (f32x4){0.f, 0.f, 0.f, 0.f};
    bf16x8 At[4][2], B0[2][2], B1[2][2];
    const char* cA = (const char*)g.A + (size_t)cur.pm * tstepA; const char* cB = (const char*)g.Bt + (size_t)cur.pn * tstep;
    S.a_ready(cur);
    if constexpr (SP2) {
        PG8_STAGE(PG8_SB(0, 0), cB, voffB); PG8_STAGE(PG8_SB(0, 1), cB + hstep, voffB); PG8_STAGE(PG8_SA(0, 0), cA, voffA); PG8_STAGE(PG8_SA(0, 1), cA + hstepA, voffA);
        if (wr == 1) PG8_BAR;
        PG8_WAIT_V(2); PG8_BAR;
        PG8_STAGE(PG8_SB(1, 0), cB + kstep, voffB); PG8_STAGE(PG8_SA(1, 0), cA + kstep, voffA); PG8_STAGE(PG8_SB(1, 1), cB + hstep + kstep, voffB);
        PG8_WAIT_V(6); PG8_BAR;
    } else {
        PG8_STAGE(PG8_SB(0, 0), cB, voffB); PG8_STAGE(PG8_SA(0, 0), cA, voffA); PG8_STAGE(PG8_SB(0, 1), cB + hstep, voffB); PG8_STAGE(PG8_SA(0, 1), cA + hstepA, voffA);
        if (wr == 1) PG8_BAR;
        PG8_WAIT_V(4); PG8_BAR;
        PG8_STAGE(PG8_SB(1, 0), cB + kstep, voffB); PG8_STAGE(PG8_SA(1, 0), cA + kstep, voffA); PG8_STAGE(PG8_SB(1, 1), cB + hstep + kstep, voffB);
        PG8_WAIT_V(6); PG8_BAR;
    }
    for (;;) {
        const bool has_next = S.next(ui + 1, nxt);
        const char* nA = has_next ? (const char*)g.A + (size_t)nxt.pm * tstepA : cA; const char* nB = has_next ? (const char*)g.Bt + (size_t)nxt.pn * tstep : cB;
        for (int t = 0; t < nt; t += 2) {
            const bool last = (t == nt - 2);
            const char* a1 = cA + (size_t)(t + 1) * kstep;
            const char* a2 = last ? nA : cA + (size_t)(t + 2) * kstep; const char* b2 = last ? nB : cB + (size_t)(t + 2) * kstep;
            const char* a3 = a2 + kstep; const char* b3 = b2 + kstep;
            if (last && has_next) S.a_ready(nxt);
            if constexpr (SP2) {
            PG8_LDB(B0, 0, 0); PG8_LDB(B1, 0, 1); PG8_SCHED; PG8_LDA(At, 0, 0); PG8_STAGE(PG8_SA(1, 1), a1 + hstepA, voffA);
            PG8_WAIT_V(8); PG8_WAIT_L(0); PG8_BAR; PG8_MMA(0, 0, At, B0); PG8_MMA(0, 1, At, B1); PG8_BAR; PG8_SCHED;
            PG8_LDA(At, 0, 1); PG8_STAGE(PG8_SB(0, 0), b2, voffB); PG8_STAGE(PG8_SB(0, 1), b2 + hstep, voffB); PG8_STAGE(PG8_SA(0, 0), a2, voffA);
            PG8_WAIT_V(8); PG8_WAIT_L(0); PG8_BAR; PG8_MMA(1, 0, At, B0); PG8_MMA(1, 1, At, B1); PG8_BAR; PG8_SCHED;
            PG8_LDB(B0, 1, 0); PG8_LDB(B1, 1, 1); PG8_SCHED; PG8_LDA(At, 1, 0); PG8_STAGE(PG8_SA(0, 1), a2 + hstepA, voffA);
            PG8_WAIT_V(8); PG8_WAIT_L(0); PG8_BAR; PG8_MMA(0, 0, At, B0); PG8_MMA(0, 1, At, B1); PG8_BAR; PG8_SCHED;
            PG8_LDA(At, 1, 1); PG8_STAGE(PG8_SB(1, 0), b3, voffB); PG8_STAGE(PG8_SB(1, 1), b3 + hstep, voffB); PG8_STAGE(PG8_SA(1, 0), a3, voffA);
            PG8_WAIT_V(8); PG8_WAIT_L(0); PG8_BAR; PG8_MMA(1, 0, At, B0); PG8_MMA(1, 1, At, B1); PG8_BAR; PG8_SCHED;
            } else {
            PG8_LDB(B0, 0, 0); PG8_SCHED; PG8_LDA(At, 0, 0); PG8_STAGE(PG8_SA(1, 1), a1 + hstepA, voffA);
            PG8_WAIT_L(8); PG8_BAR; PG8_WAIT_L(0); PG8_MMA(0, 0, At, B0); PG8_BAR; PG8_SCHED;
            PG8_LDB(B1, 0, 1); PG8_STAGE(PG8_SB(0, 0), b2, voffB);
            PG8_BAR; PG8_WAIT_L(0); PG8_MMA(0, 1, At, B1); PG8_BAR;
            PG8_LDA(At, 0, 1); PG8_STAGE(PG8_SA(0, 0), a2, voffA);
            PG8_BAR; PG8_WAIT_L(0); PG8_MMA(1, 0, At, B0); PG8_BAR; PG8_SCHED;
            PG8_STAGE(PG8_SB(0, 1), b2 + hstep, voffB);
            PG8_WAIT_V(6); PG8_BAR; PG8_MMA(1, 1, At, B1); PG8_BAR;
            PG8_LDB(B0, 1, 0); PG8_SCHED; PG8_LDA(At, 1, 0); PG8_STAGE(PG8_SA(0, 1), a2 + hstepA, voffA);
            PG8_WAIT_L(8); PG8_BAR; PG8_WAIT_L(0); PG8_MMA(0, 0, At, B0); PG8_BAR; PG8_SCHED;
            PG8_LDB(B1, 1, 1); PG8_STAGE(PG8_SB(1, 0), b3, voffB);
            PG8_BAR; PG8_WAIT_L(0); PG8_MMA(0, 1, At, B1); PG8_BAR;
            PG8_LDA(At, 1, 1); PG8_STAGE(PG8_SA(1, 0), a3, voffA);
            PG8_BAR; PG8_WAIT_L(0); PG8_MMA(1, 0, At, B0); PG8_BAR; PG8_SCHED;
            PG8_STAGE(PG8_SB(1, 1), b3 + hstep, voffB);
            PG8_WAIT_V(6); PG8_BAR; PG8_MMA(1, 1, At, B1); PG8_BAR;
            }
        }
        if constexpr (ALIGN_EPI) { if (wr == 0) PG8_BAR; }
        if constexpr (!Epi::AFTER_DRAIN) { int t2_ = threadIdx.x; asm volatile("" : "+v"(t2_)); const int w2_ = __builtin_amdgcn_readfirstlane(t2_ >> 6), l2_ = t2_ & 63; E(acc, cur, w2_ >> 2, w2_ & 3, l2_ & 15, l2_ >> 4); S.done(cur); }
        if (!has_next) break;
#pragma unroll
        for (int a = 0; a < 2; ++a)
#pragma unroll
            for (int b = 0; b < 2; ++b)
#pragma unroll
                for (int m = 0; m < 4; ++m)
#pragma unroll
                    for (int n = 0; n < 2; ++n) acc[a][b][m][n] = (f32x4){0.f, 0.f, 0.f, 0.f};
        cur = nxt; cA = nA; cB = nB; ++ui;
        if constexpr (ALIGN_EPI) { if (wr == 1) PG8_BAR; }
    }
    PG8_WAIT_V(0);
    if constexpr (!ALIGN_EPI) { if (wr == 0) PG8_BAR; }
    PG8_BAR;
    if constexpr (Epi::AFTER_DRAIN) { E.fused(acc, cur, wr, wc, fr, fq, lds, wid, lane); S.done(cur); }
#undef PG8_SA
#undef PG8_SB
#undef PG8_STAGE
#undef PG8_LDA
#undef PG8_LDB
#undef PG8_MMA
#undef PG8_WAIT_V
#undef PG8_WAIT_L
#undef PG8_BAR
#undef PG8_SCHED
}
}
#define LAS __attribute__((address_space(3)))
#define DI __device__ __forceinline__
typedef unsigned short bf16_t;
typedef short bf16x8 __attribute__((ext_vector_type(8)));
typedef short s16x4 __attribute__((ext_vector_type(4)));
typedef float f32x4 __attribute__((ext_vector_type(4)));
typedef float f32x16 __attribute__((ext_vector_type(16)));
typedef unsigned u32x4 __attribute__((ext_vector_type(4)));
typedef unsigned u32x2 __attribute__((ext_vector_type(2)));
constexpr int NTOK = 32768, DM = 1024, SEQ = 8192, FF = 4096;
constexpr int AIN = 2120, AINP = 2304, BIN = 3088, BINP = 3328;
constexpr size_t MiB = 1u << 20;
constexpr size_t WS_ROT = 1 * MiB, OFF_AIN = 4 * MiB, OFF_AO = 13 * MiB, OFF_BIN = 17 * MiB, OFF_BO = 30 * MiB, OFF_UP = 34 * MiB, OFF_DN = 66 * MiB;
constexpr size_t WS_HB = 104 * MiB, WS_R = 168 * MiB, WS_AO = 312 * MiB, WS_DS = 376 * MiB, WS_DEC = 504 * MiB, WS_END = 505 * MiB;
constexpr size_t SZ_AIN = (size_t)AINP * 1024 * 2, SZ_BIN = (size_t)BINP * 1024 * 2, SZ_SQ = 2 * MiB, SZ_FF = 8 * MiB;
constexpr int LDS_BYTES = 147456;
constexpr float DN_ALPHA = 1.681792830507429f;

#define LDS_WAIT() asm volatile("s_waitcnt lgkmcnt(0)" ::: "memory")
DI unsigned f2bf(float f) { unsigned u = __float_as_uint(f); return (u + 0x7fffu + ((u >> 16) & 1u)) >> 16; }
DI unsigned pk2(float lo, float hi) { return f2bf(lo) | (f2bf(hi) << 16); }
DI float bflo(unsigned w) { return __uint_as_float(w << 16); }
DI float bfhi(unsigned w) { return __uint_as_float(w & 0xffff0000u); }
DI float bf1(bf16_t b) { return __uint_as_float((unsigned)b << 16); }
DI float wave_sum(float v) {
#pragma unroll
    for (int o = 1; o < 64; o <<= 1) v += __shfl_xor(v, o);
    return v;
}
DI int my_tid() { int t = threadIdx.x; asm volatile("" : "+v"(t)); return t; }
DI int my_bid() { int b = blockIdx.x; asm volatile("" : "+s"(b)); return b; }
DI int my_bid_v() { int b = blockIdx.x; asm volatile("" : "+v"(b)); return b; }
DI int wave_isum(int v) {
#pragma unroll
    for (int o = 1; o < 64; o <<= 1) v += __shfl_xor(v, o);
    return v;
}
DI int crow(int i, int h) { return (i & 3) + 8 * (i >> 2) + 4 * h; }
#define MFMA32(a, b, c) __builtin_amdgcn_mfma_f32_32x32x16_bf16((a), (b), (c), 0, 0, 0)
#define MFMA16(a, b, c) __builtin_amdgcn_mfma_f32_16x16x32_bf16((a), (b), (c), 0, 0, 0)

DI void transpose_matrix(const float* W, int K, int N, int Np, bf16_t* WT, LAS float* scr, int gw, int ngw, int lane) {
    const int nbn = Np >> 6, nit = (K >> 6) * nbn;
    for (int it = gw; it < nit; it += ngw) {
        const int k0 = (it / nbn) << 6, n0 = (it % nbn) << 6;
        const int n = n0 + lane; const bool ok = n < N;
        const float* src = W + (size_t)k0 * N + n;
#pragma unroll 8
        for (int kk = 0; kk < 64; ++kk) scr[kk * 65 + lane] = ok ? src[(size_t)kk * N] : 0.f;
        LDS_WAIT();
        const int c = lane & 7, nr = lane >> 3;
#pragma unroll
        for (int j = 0; j < 8; ++j) { const int nn = nr + 8 * j; const LAS float* s = scr + (8 * c) * 65 + nn;
            u32x4 o; o.x = pk2(s[0], s[65]); o.y = pk2(s[130], s[195]); o.z = pk2(s[260], s[325]); o.w = pk2(s[390], s[455]);
            *(u32x4*)(WT + (size_t)(n0 + nn) * K + k0 + 8 * c) = o; }
        LDS_WAIT();
    }
}
DI void rot_table(const int* pos, float* rot, int gtid, int gt) {
    for (int idx = gtid; idx < NTOK * 8; idx += gt) {
        const int t = idx >> 3, i = idx & 7;
        const double inv = i == 0 ? 1.0 : i == 1 ? 0.19392274474868576 : i == 2 ? 0.03760603093086393 : i == 3 ? 0.007292664737217109 : i == 4 ? 0.001414213562373095 :
                           i == 5 ? 0.0002742481756762073 : i == 6 ? 5.318295896944988e-05 : 1.031338537721246e-05;
        const double x = (double)pos[t] * inv;
        const double n = rint(x * 0.15915494309189535);
        const double r = fma(-n, 6.283185307179586, x) - n * 2.4492935982947064e-16;
        const double r2 = r * r;
        double ts = r, ss = r, tc = 1.0, sc = 1.0;
#pragma unroll
        for (int k = 1; k <= 14; ++k) { ts *= -r2 / (double)((2 * k) * (2 * k + 1)); ss += ts; tc *= -r2 / (double)((2 * k - 1) * (2 * k)); sc += tc; }
        rot[t * 16 + i] = (float)sc; rot[t * 16 + 8 + i] = (float)ss;
    }
}
DI void ln_phase(float* hbuf, bf16_t* hb, const float* g, const float* b, int gw, int ngw, int lane) {
    for (int m = gw; m < NTOK; m += ngw) {
        f32x4* row = (f32x4*)(hbuf + (size_t)m * DM) + lane; f32x4 v[4]; float s = 0.f;
#pragma unroll
        for (int j = 0; j < 4; ++j) { v[j] = row[64 * j]; s += (v[j].x + v[j].y) + (v[j].z + v[j].w); }
        const float mean = wave_sum(s) * (1.f / DM); float s2 = 0.f;
#pragma unroll
        for (int j = 0; j < 4; ++j) { v[j] = v[j] - mean; s2 += (v[j].x * v[j].x + v[j].y * v[j].y) + (v[j].z * v[j].z + v[j].w * v[j].w); }
        const float rstd = 1.f / sqrtf(wave_sum(s2) * (1.f / DM) + 1e-5f);
        u32x2* o8 = (u32x2*)(hb + (size_t)m * DM) + lane;
#pragma unroll
        for (int j = 0; j < 4; ++j) { const f32x4 gg = ((const f32x4*)g)[lane + 64 * j], bb = ((const f32x4*)b)[lane + 64 * j];
            const f32x4 o = v[j] * rstd * gg + bb; row[64 * j] = o; u32x2 w; w.x = pk2(o.x, o.y); w.y = pk2(o.z, o.w); o8[64 * j] = w; }
    }
}
DI void rotary_phase(bf16_t* proj, const float* rot, int gtid, int gt) {
    for (int idx = gtid; idx < NTOK * 29; idx += gt) {
        const int t = idx / 29, hh = idx - t * 29;
        const int col = hh < 16 ? hh * 64 : hh < 20 ? 1024 + (hh - 16) * 64 : hh < 28 ? 1536 + (hh - 20) * 64 : 2048;
        bf16_t* p = proj + (size_t)t * AINP + col;
        const u32x4 a = *(const u32x4*)p, bq = *(const u32x4*)(p + 8);
        const f32x4 c0 = *(const f32x4*)(rot + t * 16), c1 = *(const f32x4*)(rot + t * 16 + 4), s0 = *(const f32x4*)(rot + t * 16 + 8), s1 = *(const f32x4*)(rot + t * 16 + 12);
        u32x4 oa, ob;
#define ROT2(W, CA, SA, CB, SB) { const float t1a = bflo(a.W), t1b = bfhi(a.W), t2a = bflo(bq.W), t2b = bfhi(bq.W); \
        oa.W = pk2(t1a * CA - t2a * SA, t1b * CB - t2b * SB); ob.W = pk2(t2a * CA + t1a * SA, t2b * CB + t1b * SB); }
        ROT2(x, c0.x, s0.x, c0.y, s0.y) ROT2(y, c0.z, s0.z, c0.w, s0.w) ROT2(z, c1.x, s1.x, c1.y, s1.y) ROT2(w, c1.z, s1.z, c1.w, s1.w)
#undef ROT2
        *(u32x4*)p = oa; *(u32x4*)(p + 8) = ob;
    }
}
template <int OFF> DI void tr_read8(unsigned addr, s16x4 (&r)[8]) {
    asm volatile("ds_read_b64_tr_b16 %0, %8 offset:%9\n\tds_read_b64_tr_b16 %1, %8 offset:%10\n\tds_read_b64_tr_b16 %2, %8 offset:%11\n\tds_read_b64_tr_b16 %3, %8 offset:%12\n\t"
                 "ds_read_b64_tr_b16 %4, %8 offset:%13\n\tds_read_b64_tr_b16 %5, %8 offset:%14\n\tds_read_b64_tr_b16 %6, %8 offset:%15\n\tds_read_b64_tr_b16 %7, %8 offset:%16\n\ts_waitcnt lgkmcnt(0)"
                 : "=&v"(r[0]), "=&v"(r[1]), "=&v"(r[2]), "=&v"(r[3]), "=&v"(r[4]), "=&v"(r[5]), "=&v"(r[6]), "=&v"(r[7])
                 : "v"(addr), "n"(OFF), "n"(OFF + 2112), "n"(OFF + 32), "n"(OFF + 32 + 2112), "n"(OFF + 64), "n"(OFF + 64 + 2112), "n"(OFF + 96), "n"(OFF + 96 + 2112) : "memory");
}
constexpr int VROW = 528;
constexpr int D_SAMP = 0, D_CVAL = 32768, D_CIDX = 65536, D_SEL = 135168, D_CTL = 139264, D_CAP = 1024, D_IMG = 16896, D_FBIMG = 32768;
DI unsigned sortable(float v) { const unsigned u = __float_as_uint(v + 0.f); return (u >> 31) ? ~u : (u | 0x80000000u); }
DI void score_tile(const bf16x8 (&a)[4], const bf16x8 (&bb)[4], const float (&w)[4][4], float (&s4)[4]) {
    f32x16 x;
#pragma unroll
    for (int i = 0; i < 16; ++i) x[i] = 0.f;
#pragma unroll
    for (int ks = 0; ks < 4; ++ks) x = MFMA32(a[ks], bb[ks], x);
#pragma unroll
    for (int qq = 0; qq < 4; ++qq) { float s = w[qq][0] * fmaxf(x[4 * qq], 0.f); s += w[qq][1] * fmaxf(x[4 * qq + 1], 0.f); s += w[qq][2] * fmaxf(x[4 * qq + 2], 0.f); s += w[qq][3] * fmaxf(x[4 * qq + 3], 0.f);
        s += __shfl_xor(s, 32); s4[qq] = s; }
}
DI void load_iq(const bf16_t* proj, int tokr, int r, int h, bf16x8 (&a)[4], float (&w)[4][4]) {
    const bf16_t* p = proj + (size_t)(tokr + (r >> 3)) * AINP + 1536 + (r & 7) * 64 + 8 * h;
#pragma unroll
    for (int ks = 0; ks < 4; ++ks) a[ks] = *(const bf16x8*)(p + ks * 16);
#pragma unroll
    for (int qq = 0; qq < 4; ++qq) { const u32x2 wv = *(const u32x2*)(proj + (size_t)(tokr + qq) * AINP + 2112 + 4 * h);
        const float sc_ = 0.35355339059327373f * 0.125f; w[qq][0] = bflo(wv.x) * sc_; w[qq][1] = bfhi(wv.x) * sc_; w[qq][2] = bflo(wv.y) * sc_; w[qq][3] = bfhi(wv.y) * sc_; }
}
DI void load_ik(const bf16_t* kp0, int kt, bf16x8 (&bb)[4]) {
    const bf16_t* kp = kp0 + (size_t)(kt * 32) * AINP;
#pragma unroll
    for (int ks = 0; ks < 4; ++ks) bb[ks] = *(const bf16x8*)(kp + ks * 16);
}
DI void full_select(const LAS unsigned* row, int nround, LAS unsigned short* sl, int lane) {
    asm volatile("" : "+v"(lane));
    unsigned T = 0u;
    for (int bit = 31; bit >= 0; --bit) { const unsigned cand = T | (1u << bit); int cnt = 0;
#pragma unroll 4
        for (int i = lane * 4; i < nround; i += 256) { const u32x4 v = *(const LAS u32x4*)(row + i);
            cnt += (int)(v.x >= cand) + (int)(v.y >= cand) + (int)(v.z >= cand) + (int)(v.w >= cand); }
        cnt = wave_isum(cnt); if (cnt >= 256) T = cand; }
    int cgt = 0;
#pragma unroll 4
    for (int i = lane * 4; i < nround; i += 256) { const u32x4 v = *(const LAS u32x4*)(row + i);
        cgt += (int)(v.x > T) + (int)(v.y > T) + (int)(v.z > T) + (int)(v.w > T); }
    cgt = wave_isum(cgt);
    const int need = 256 - cgt; int base = 0, eqb = 0; const unsigned long long ltm = (1ull << lane) - 1ull;
    for (int i0 = 0; i0 < nround; i0 += 64) { const unsigned u = row[i0 + lane]; const bool gt = u > T, eq = u == T;
        const unsigned long long me = __ballot(eq); const bool take = gt || (eq && (eqb + __popcll(me & ltm)) < need);
        const unsigned long long mt = __ballot(take); if (take) sl[base + __popcll(mt & ltm)] = (unsigned short)(i0 + lane);
        base += __popcll(mt); eqb += __popcll(me); }
}
DI void dsa_attend(const bf16_t* proj, bf16_t* ao, int tok, int b, int nsel, const LAS unsigned short* sl, LAS unsigned char* vimg, int lane) {
    asm volatile("" : "+v"(lane));
    const int fr = lane & 15, fq = lane >> 4;
    bf16x8 qa, qb, qz;
    { const bf16_t* qp = proj + (size_t)tok * AINP + fr * 64 + fq * 8; qa = *(const bf16x8*)qp; qb = *(const bf16x8*)(qp + 32);
#pragma unroll
      for (int i = 0; i < 8; ++i) qz[i] = 0; }
    const int qg = fr >> 2;
#define QF(st) ((((st) >> 1) == qg) ? (((st) & 1) ? qb : qa) : qz)
    const bf16_t* kbase = proj + (size_t)(b * SEQ) * AINP + 1024 + fq * 8;
    const int ntl = (nsel + 15) >> 4;
    f32x4 sacc[16];
#pragma unroll
    for (int jt = 0; jt < 16; ++jt) {
        f32x4 acc = (f32x4){0.f, 0.f, 0.f, 0.f};
        if (jt < ntl) { const int kidx = sl[jt * 16 + fr]; const bf16_t* kr = kbase + (size_t)kidx * AINP;
#pragma unroll
            for (int st = 0; st < 8; ++st) acc = MFMA16(*(const bf16x8*)(kr + st * 32), QF(st), acc); }
#pragma unroll
        for (int j = 0; j < 4; ++j) if (jt * 16 + 4 * fq + j >= nsel) acc[j] = -INFINITY;
        sacc[jt] = acc;
    }
#undef QF
    float mx = -INFINITY;
#pragma unroll
    for (int jt = 0; jt < 16; ++jt) mx = fmaxf(mx, fmaxf(fmaxf(sacc[jt][0], sacc[jt][1]), fmaxf(sacc[jt][2], sacc[jt][3])));
    mx = fmaxf(mx, __shfl_xor(mx, 16)); mx = fmaxf(mx, __shfl_xor(mx, 32));
    float sum = 0.f; bf16x8 pf[8];
#pragma unroll
    for (int s = 0; s < 8; ++s) { float p[8];
#pragma unroll
        for (int j = 0; j < 4; ++j) { p[j] = __builtin_amdgcn_exp2f((sacc[2 * s][j] - mx) * (0.125f * 1.4426950408889634f)); p[4 + j] = __builtin_amdgcn_exp2f((sacc[2 * s + 1][j] - mx) * (0.125f * 1.4426950408889634f)); }
        u32x4 pw; pw.x = pk2(p[0], p[1]); pw.y = pk2(p[2], p[3]); pw.z = pk2(p[4], p[5]); pw.w = pk2(p[6], p[7]);
        sum += ((p[0] + p[1]) + (p[2] + p[3])) + ((p[4] + p[5]) + (p[6] + p[7]));
        pf[s] = __builtin_bit_cast(bf16x8, pw); }
    sum += __shfl_xor(sum, 16); sum += __shfl_xor(sum, 32);
    const float inv = 1.f / sum;
    f32x4 oacc[16];
#pragma unroll
    for (int dt = 0; dt < 16; ++dt) oacc[dt] = (f32x4){0.f, 0.f, 0.f, 0.f};
    const bf16_t* vbase = proj + (size_t)(b * SEQ) * AINP + 1280 + (lane & 31) * 8;
    const unsigned traddr = (unsigned)(size_t)vimg + (unsigned)((8 * fq + ((lane >> 2) & 3)) * VROW + 8 * (lane & 3));
    u32x4 vld[16];
#define VGATHER(S) { _Pragma("unroll") for (int u = 0; u < 16; ++u) { const int rho = u * 2 + (lane >> 5); const int fqr = rho >> 3, j = rho & 7; \
        const int pos = (2 * (S) + (j >> 2)) * 16 + 4 * fqr + (j & 3); const int kidx = sl[pos]; vld[u] = *(const u32x4*)(vbase + (size_t)kidx * AINP); } }
    VGATHER(0)
#pragma unroll
    for (int s = 0; s < 8; ++s) {
        if (2 * s < ntl) {
#pragma unroll
            for (int u = 0; u < 16; ++u) { const int rho = u * 2 + (lane >> 5); *(LAS u32x4*)(vimg + rho * VROW + (lane & 31) * 16) = vld[u]; }
            if (s < 7) { if (2 * (s + 1) < ntl) VGATHER(s + 1) }
            LDS_WAIT();
            s16x4 t8[8];
#define PV4(T0) tr_read8<(T0) * 32>(traddr, t8); \
            oacc[T0] = MFMA16(pf[s], __builtin_shufflevector(t8[0], t8[1], 0, 1, 2, 3, 4, 5, 6, 7), oacc[T0]); \
            oacc[T0 + 1] = MFMA16(pf[s], __builtin_shufflevector(t8[2], t8[3], 0, 1, 2, 3, 4, 5, 6, 7), oacc[T0 + 1]); \
            oacc[T0 + 2] = MFMA16(pf[s], __builtin_shufflevector(t8[4], t8[5], 0, 1, 2, 3, 4, 5, 6, 7), oacc[T0 + 2]); \
            oacc[T0 + 3] = MFMA16(pf[s], __builtin_shufflevector(t8[6], t8[7], 0, 1, 2, 3, 4, 5, 6, 7), oacc[T0 + 3]);
            PV4(0) PV4(4) PV4(8) PV4(12)
#undef PV4
        }
    }
#undef VGATHER
    float ivj[4];
#pragma unroll
    for (int j = 0; j < 4; ++j) ivj[j] = __shfl(inv, 4 * fq + j);
#pragma unroll
    for (int dt = 0; dt < 16; ++dt) if (fq == (dt >> 2)) {
#pragma unroll
        for (int j = 0; j < 4; ++j) ao[(size_t)tok * DM + (4 * fq + j) * 64 + (dt & 3) * 16 + fr] = (bf16_t)f2bf(oacc[dt][j] * ivj[j]); }
}
#define CNT16(V, EXPR) ({ int c_ = 0; _Pragma("unroll") for (int i_ = 0; i_ < 16; ++i_) { const unsigned x_ = V[i_]; (void)x_; c_ += __popcll(__ballot(EXPR)); } c_; })
DI void dsa_phase(LAS unsigned char* lds, const bf16_t* proj, bf16_t* ao) {
    LAS unsigned* samp = (LAS unsigned*)(lds + D_SAMP); LAS unsigned* cval = (LAS unsigned*)(lds + D_CVAL); LAS unsigned short* cidx = (LAS unsigned short*)(lds + D_CIDX);
    LAS unsigned short* sel = (LAS unsigned short*)(lds + D_SEL); LAS unsigned* ctl = (LAS unsigned*)(lds + D_CTL);
    const int tid0 = my_tid(), wid = __builtin_amdgcn_readfirstlane(tid0 >> 6);
    const int bid0 = my_bid(), G0 = gridDim.x; const bool xmap = (G0 == 256);
    const int gfirst = xmap ? ((bid0 & 7) >> 1) * 1024 + (bid0 >> 3) + 32 * (bid0 & 1) : bid0, gstep = xmap ? 64 : G0, gend = xmap ? ((bid0 & 7) >> 1) * 1024 + 1024 : NTOK / 8;
    for (int g = gfirst; g < gend; g += gstep) {
        int lane = tid0 & 63; asm volatile("" : "+v"(lane));
        const int r = lane & 31, h = lane >> 5, tid = wid * 64 + lane;
        const int tok0 = g * 8, b = tok0 >> 13, s0 = tok0 & (SEQ - 1);
        const int ntile = (s0 + 8 + 31) >> 5;
        const bf16_t* kp0 = proj + (size_t)(b * SEQ + r) * AINP + 2048 + 8 * h;
        bf16x8 a0[4], a1[4]; float w0[4][4], w1[4][4];
        load_iq(proj, tok0, r, h, a0, w0); load_iq(proj, tok0 + 4, r, h, a1, w1);
        for (int st = wid; st < 32; st += 8) {
            const int kt = (st >> 1) * 16 + (st & 1); const int key = kt * 32 + r;
            unsigned u[4] = {0u, 0u, 0u, 0u};
            if (kt < ntile) { bf16x8 bb[4]; load_ik(kp0, kt, bb); float s4[4];
                score_tile(a0, bb, w0, s4); u[0] = sortable(h ? s4[2] : s4[0]); u[1] = sortable(h ? s4[3] : s4[1]);
                score_tile(a1, bb, w1, s4); u[2] = sortable(h ? s4[2] : s4[0]); u[3] = sortable(h ? s4[3] : s4[1]); }
#pragma unroll
            for (int e = 0; e < 4; ++e) { const int q = 4 * (e >> 1) + 2 * h + (e & 1); samp[q * 1024 + st * 32 + r] = (key > s0 + q) ? 0u : u[e]; }
        }
        __syncthreads();
        {   const int q = wid, n = s0 + q + 1; unsigned thr = 1u;
            if (n > 1024) { const int rem = n & 511; const int ns = 64 * (n >> 9) + (rem < 64 ? rem : 64); int rs = (448 * ns + n - 1) / n; rs = rs < 8 ? 8 : rs;
                unsigned sv[16];
#pragma unroll
                for (int i = 0; i < 16; ++i) sv[i] = samp[q * 1024 + lane + 64 * i];
                unsigned T = 0u;
                for (int bit = 31; bit >= 0; --bit) { const unsigned cand = T | (1u << bit); const int c = CNT16(sv, x_ >= cand); if (c >= rs) T = cand; }
                thr = T > 1u ? T : 1u; }
            if (lane == 0) { ctl[q] = thr; ctl[16 + q] = 0u; } }
        __syncthreads();
        {   unsigned th[4], cl[4] = {0u, 0u, 0u, 0u}, ch[4] = {0u, 0u, 0u, 0u};
#pragma unroll
            for (int e = 0; e < 4; ++e) th[e] = ctl[4 * (e >> 1) + 2 * h + (e & 1)];
            bf16x8 bb[4]; load_ik(kp0, wid < ntile ? wid : ntile - 1, bb);
            for (int kt = wid; kt < ntile; kt += 8) {
                bf16x8 nb[4]; load_ik(kp0, (kt + 8 < ntile) ? kt + 8 : ntile - 1, nb);
                const int key = kt * 32 + r; unsigned u[4]; float s4[4];
                score_tile(a0, bb, w0, s4); u[0] = sortable(h ? s4[2] : s4[0]); u[1] = sortable(h ? s4[3] : s4[1]);
                score_tile(a1, bb, w1, s4); u[2] = sortable(h ? s4[2] : s4[0]); u[3] = sortable(h ? s4[3] : s4[1]);
#pragma unroll
                for (int e = 0; e < 4; ++e) { const int q = 4 * (e >> 1) + 2 * h + (e & 1); const unsigned uu = (key > s0 + q) ? 0u : u[e];
                    const bool pass = uu >= th[e]; const unsigned long long m = __ballot(pass);
                    if (m) { const unsigned mlo = (unsigned)m, mhi = (unsigned)(m >> 32); const unsigned mh = h ? mhi : mlo, base = h ? ch[e] : cl[e];
                        if (pass) { const unsigned p = base + __popc(mh & ((1u << r) - 1u)); if (p < 128u) { const int ix = q * D_CAP + wid * 128 + (int)p; cval[ix] = uu; cidx[ix] = (unsigned short)key; } }
                        cl[e] += __popc(mlo); ch[e] += __popc(mhi); } }
#pragma unroll
                for (int ks = 0; ks < 4; ++ks) bb[ks] = nb[ks];
            }
            if (lane == 0) {
#pragma unroll
                for (int e = 0; e < 4; ++e) { ctl[24 + (4 * (e >> 1) + (e & 1)) * 8 + wid] = cl[e]; ctl[24 + (4 * (e >> 1) + 2 + (e & 1)) * 8 + wid] = ch[e]; } } }
        __syncthreads();
        int nsel = 0; bool fb = false;
        {   asm volatile("" : "+v"(lane)); const unsigned long long ltm = (1ull << lane) - 1ull;
            const int q = wid; LAS unsigned short* sl = sel + q * 256; const unsigned thr = ctl[q];
            unsigned cw[8], cnt = 0u; bool ovf = false;
#pragma unroll
            for (int w = 0; w < 8; ++w) { cw[w] = ctl[24 + q * 8 + w]; cnt += cw[w]; ovf = ovf || (cw[w] > 128u); }
            if (ovf || (thr > 1u && cnt < 256u)) { fb = true; if (lane == 0) ctl[16 + q] = 1u; }
            else { unsigned cv[16], ci[16];
#pragma unroll
                for (int i = 0; i < 16; ++i) { const unsigned o = (i & 1) * 64 + lane; const bool in = o < cw[i >> 1]; const int ix = q * D_CAP + (i >> 1) * 128 + (int)o;
                    cv[i] = in ? cval[ix] : 0u; ci[i] = in ? (unsigned)cidx[ix] : 0xffffu; }
                unsigned T = 0u, I = 0xffffu;
                if (cnt <= 256u) nsel = (int)cnt;
                else { nsel = 256;
                    for (int bit = 31; bit >= 0; --bit) { const unsigned cand = T | (1u << bit); const int c = CNT16(cv, x_ >= cand); if (c >= 256) T = cand; }
                    const int cgt = CNT16(cv, x_ > T), ceq = CNT16(cv, x_ == T), need = 256 - cgt;
                    if (ceq > need) { I = 0u;
                        for (int bit = 13; bit >= 0; --bit) { const unsigned cand = I | (1u << bit); int c = 0;
#pragma unroll
                            for (int i = 0; i < 16; ++i) c += __popcll(__ballot(cv[i] == T && ci[i] < cand));
                            if (c < need) I = cand; } } }
                int base = 0;
#pragma unroll
                for (int i = 0; i < 16; ++i) { const bool take = cv[i] > T || (cv[i] == T && ci[i] <= I && T != 0u); const unsigned long long mt = __ballot(take);
                    if (take) sl[base + __popcll(mt & ltm)] = (unsigned short)ci[i]; base += __popcll(mt); }
#pragma unroll
                for (int i = 0; i < 4; ++i) { const int p = lane + 64 * i; if (p >= nsel) sl[p] = (unsigned short)0; } }
            LDS_WAIT(); }
        __syncthreads();
        if (!fb) dsa_attend(proj, ao, tok0 + wid, b, nsel, sel + wid * 256, lds + wid * D_IMG, lane);
        __syncthreads();
        for (int q = 0; q < 8; ++q) {
            if (ctl[16 + q] == 0u) continue;
            LAS unsigned* row = (LAS unsigned*)lds; const int n = s0 + q + 1, ntq = (n + 31) >> 5, nround = (ntq * 32 + 255) & ~255;
            bf16x8 af[4]; float wf[4][4]; load_iq(proj, tok0 + (q & 4), r, h, af, wf);
            for (int kt = wid; kt < ntq; kt += 8) { bf16x8 bb[4]; load_ik(kp0, kt, bb); float s4[4];
                score_tile(af, bb, wf, s4);
                const int key = kt * 32 + r; const int ql = q & 3; const float sv = (ql == 0) ? s4[0] : (ql == 1) ? s4[1] : (ql == 2) ? s4[2] : s4[3];
                if (h == 0) row[key] = (key >= n) ? 0u : sortable(sv); }
            for (int i = ntq * 32 + tid; i < nround; i += 512) row[i] = 0u;
            __syncthreads();
            if (wid == 0) { full_select(row, nround, sel, lane); LDS_WAIT(); dsa_attend(proj, ao, tok0 + q, b, 256, sel, lds + D_FBIMG, lane); }
            __syncthreads();
        }
    }
}
constexpr int G_ALOW = 0, G_BC = 4096, G_TOT = 36864, G_KST = 38912, G_VT = 57344, G_QI = 94208, G_KI = 111616, G_AT = 129024, G_PART = 138240;
DI void gla_gate(LAS unsigned char* lds, const bf16_t* proj, const float* w_a2, const float* b_a, int t0, int hh, int tid) {
    LAS float* alow = (LAS float*)(lds + G_ALOW); LAS float* bc = (LAS float*)(lds + G_BC); LAS float* tot = (LAS float*)(lds + G_TOT);
    for (int i = tid; i < 1024; i += 512) alow[i] = bf1(proj[(size_t)(t0 + (i >> 4)) * BINP + 3072 + (i & 15)]);
    __syncthreads();
    const int d = tid & 127, jg = tid >> 7;
    float wv[16];
#pragma unroll
    for (int rr = 0; rr < 16; ++rr) wv[rr] = w_a2[rr * 512 + hh * 128 + d];
    const float bias = b_a[hh * 128 + d];
    float gl[16]; float run = 0.f;
#pragma unroll
    for (int jj = 0; jj < 16; ++jj) { const LAS f32x4* ap = (const LAS f32x4*)(alow + (jg * 16 + jj) * 16); float z = bias;
#pragma unroll
        for (int q4 = 0; q4 < 4; ++q4) { const f32x4 av = ap[q4]; z += av.x * wv[4 * q4] + av.y * wv[4 * q4 + 1] + av.z * wv[4 * q4 + 2] + av.w * wv[4 * q4 + 3]; }
        const float ls = fminf(z, 0.f) - __logf(1.f + __expf(-fabsf(z)));
        run += ls * 0.0625f; gl[jj] = run; }
    tot[jg * 128 + d] = run;
    __syncthreads();
    float off = 0.f;
#pragma unroll
    for (int q = 0; q < 3; ++q) if (q < jg) off += tot[q * 128 + d];
#pragma unroll
    for (int jj = 0; jj < 16; ++jj) bc[(jg * 16 + jj) * 128 + d] = off + gl[jj];
    __syncthreads();
}
DI void gla_load_vt(LAS unsigned char* lds, const bf16_t* proj, int t0, int hh, int tid) {
    LAS bf16_t* vt = (LAS bf16_t*)(lds + G_VT);
    for (int it = tid; it < 2048; it += 512) { const int j = it >> 5, e0 = (it & 31) * 8;
        const u32x4 vv = *(const u32x4*)(proj + (size_t)(t0 + j) * BINP + 1024 + hh * 256 + e0);
        vt[(e0 + 0) * 72 + j] = (bf16_t)(vv.x & 0xffffu); vt[(e0 + 1) * 72 + j] = (bf16_t)(vv.x >> 16); vt[(e0 + 2) * 72 + j] = (bf16_t)(vv.y & 0xffffu); vt[(e0 + 3) * 72 + j] = (bf16_t)(vv.y >> 16);
        vt[(e0 + 4) * 72 + j] = (bf16_t)(vv.z & 0xffffu); vt[(e0 + 5) * 72 + j] = (bf16_t)(vv.z >> 16); vt[(e0 + 6) * 72 + j] = (bf16_t)(vv.w & 0xffffu); vt[(e0 + 7) * 72 + j] = (bf16_t)(vv.w >> 16); }
}
DI void gla_g1(LAS unsigned char* lds, const bf16_t* proj, const float* w_a2, const float* b_a, bf16_t* DS, float* DEC) {
    const int tid = my_tid(), wid = tid >> 6, lane = tid & 63, r = lane & 31, h = lane >> 5;
    LAS float* bc = (LAS float*)(lds + G_BC); LAS bf16_t* kst = (LAS bf16_t*)(lds + G_KST); LAS bf16_t* vt = (LAS bf16_t*)(lds + G_VT);
    for (int unit = my_bid_v(); unit < 2048; unit += gridDim.x) {
        const int b = unit >> 9, hh = (unit >> 7) & 3, c = unit & 127, t0 = b * SEQ + c * 64;
        gla_gate(lds, proj, w_a2, b_a, t0, hh, tid);
        for (int it = tid; it < 1024; it += 512) { const int j = it >> 4, d0 = (it & 15) * 8;
            const u32x4 kv = *(const u32x4*)(proj + (size_t)(t0 + j) * BINP + 512 + hh * 128 + d0);
            const unsigned kw[4] = {kv.x, kv.y, kv.z, kv.w};
#pragma unroll
            for (int i = 0; i < 8; ++i) { const int d = d0 + i; const float kf = (i & 1) ? bfhi(kw[i >> 1]) : bflo(kw[i >> 1]);
                kst[d * 72 + j] = (bf16_t)f2bf(kf * __expf(bc[63 * 128 + d] - bc[j * 128 + d])); } }
        gla_load_vt(lds, proj, t0, hh, tid);
        if (tid < 128) DEC[(size_t)unit * 128 + tid] = __expf(bc[63 * 128 + tid]);
        __syncthreads();
        bf16x8 a[4];
#pragma unroll
        for (int ks = 0; ks < 4; ++ks) a[ks] = *(const LAS bf16x8*)(vt + (32 * wid + r) * 72 + ks * 16 + 8 * h);
#pragma unroll
        for (int nt = 0; nt < 4; ++nt) { f32x16 x;
#pragma unroll
            for (int i = 0; i < 16; ++i) x[i] = 0.f;
#pragma unroll
            for (int ks = 0; ks < 4; ++ks) x = MFMA32(a[ks], *(const LAS bf16x8*)(kst + (nt * 32 + r) * 72 + ks * 16 + 8 * h), x);
#pragma unroll
            for (int i = 0; i < 16; ++i) DS[((size_t)unit * 256 + 32 * wid + crow(i, h)) * 128 + nt * 32 + r] = (bf16_t)f2bf(x[i]); }
        __syncthreads();
    }
}
DI void gla_g2(bf16_t* DS, const float* DEC, int gtid, int gt) {
    for (int idx = gtid; idx < 131072; idx += gt) {
        const int bh = idx >> 13, e = (idx >> 5) & 255, d0 = (idx & 31) * 4;
        bf16_t* p = DS + ((size_t)(bh * 128) * 256 + e) * 128 + d0; const float* dp = DEC + (size_t)bh * 128 * 128 + d0;
        float S0 = 0.f, S1 = 0.f, S2 = 0.f, S3 = 0.f;
#pragma unroll 8
        for (int c = 0; c < 128; ++c) { const u32x2 v = *(const u32x2*)(p + (size_t)c * 32768); const f32x4 dc = *(const f32x4*)(dp + c * 128);
            u32x2 o; o.x = pk2(S0, S1); o.y = pk2(S2, S3); *(u32x2*)(p + (size_t)c * 32768) = o;
            S0 = dc.x * S0 + bflo(v.x); S1 = dc.y * S1 + bfhi(v.x); S2 = dc.z * S2 + bflo(v.y); S3 = dc.w * S3 + bfhi(v.y); }
    }
}
DI void gla_g3(LAS unsigned char* lds, bf16_t* proj, const float* w_a2, const float* b_a, const float* g_norm, const bf16_t* DS) {
    const int tid = my_tid(), wid = tid >> 6, lane = tid & 63, r = lane & 31, h = lane >> 5;
    LAS float* bc = (LAS float*)(lds + G_BC); LAS bf16_t* vt = (LAS bf16_t*)(lds + G_VT); LAS bf16_t* qi = (LAS bf16_t*)(lds + G_QI); LAS bf16_t* ki = (LAS bf16_t*)(lds + G_KI);
    LAS bf16_t* at = (LAS bf16_t*)(lds + G_AT); LAS float* part = (LAS float*)(lds + G_PART);
    for (int unit = my_bid_v(); unit < 2048; unit += gridDim.x) {
        const int b = unit >> 9, hh = (unit >> 7) & 3, c = unit & 127, t0 = b * SEQ + c * 64;
        gla_gate(lds, proj, w_a2, b_a, t0, hh, tid);
        for (int it = tid; it < 1024; it += 512) { const int j = it >> 4, d0 = (it & 15) * 8;
            const bf16_t* rp = proj + (size_t)(t0 + j) * BINP + hh * 128 + d0;
            const u32x4 qv = *(const u32x4*)rp, kv = *(const u32x4*)(rp + 512);
            const f32x4 b0 = *(const LAS f32x4*)(bc + j * 128 + d0), b1 = *(const LAS f32x4*)(bc + j * 128 + d0 + 4);
            const float bv[8] = {b0.x, b0.y, b0.z, b0.w, b1.x, b1.y, b1.z, b1.w};
            const unsigned qw[4] = {qv.x, qv.y, qv.z, qv.w}, kw[4] = {kv.x, kv.y, kv.z, kv.w};
            float qo[8], ko[8];
#pragma unroll
            for (int i = 0; i < 8; ++i) { const float qf = (i & 1) ? bfhi(qw[i >> 1]) : bflo(qw[i >> 1]), kf = (i & 1) ? bfhi(kw[i >> 1]) : bflo(kw[i >> 1]);
                qo[i] = qf * 0.08838834764831845f * __expf(bv[i]); ko[i] = kf * __expf(-bv[i]); }
            u32x4 qp, kp; qp.x = pk2(qo[0], qo[1]); qp.y = pk2(qo[2], qo[3]); qp.z = pk2(qo[4], qo[5]); qp.w = pk2(qo[6], qo[7]);
            kp.x = pk2(ko[0], ko[1]); kp.y = pk2(ko[2], ko[3]); kp.z = pk2(ko[4], ko[5]); kp.w = pk2(ko[6], ko[7]);
            *(LAS u32x4*)(qi + j * 136 + d0) = qp; *(LAS u32x4*)(ki + j * 136 + d0) = kp; }
        gla_load_vt(lds, proj, t0, hh, tid);
        __syncthreads();
        if (wid < 4) { const int it_ = wid >> 1, jt = wid & 1; f32x16 x;
#pragma unroll
            for (int i = 0; i < 16; ++i) x[i] = 0.f;
#pragma unroll
            for (int ks = 0; ks < 8; ++ks) x = MFMA32(*(const LAS bf16x8*)(qi + (it_ * 32 + r) * 136 + ks * 16 + 8 * h), *(const LAS bf16x8*)(ki + (jt * 32 + r) * 136 + ks * 16 + 8 * h), x);
#pragma unroll
            for (int i = 0; i < 16; ++i) { const int ii = it_ * 32 + crow(i, h), jj = jt * 32 + r; at[ii * 72 + jj] = (bf16_t)((jj <= ii) ? f2bf(x[i]) : 0u); } }
        __syncthreads();
        f32x16 o0, o1;
#pragma unroll
        for (int i = 0; i < 16; ++i) { o0[i] = 0.f; o1[i] = 0.f; }
#pragma unroll
        for (int ks = 0; ks < 4; ++ks) { const bf16x8 a = *(const LAS bf16x8*)(vt + (32 * wid + r) * 72 + ks * 16 + 8 * h);
            o0 = MFMA32(a, *(const LAS bf16x8*)(at + r * 72 + ks * 16 + 8 * h), o0); o1 = MFMA32(a, *(const LAS bf16x8*)(at + (32 + r) * 72 + ks * 16 + 8 * h), o1); }
        { const bf16_t* sp = DS + ((size_t)unit * 256 + 32 * wid + r) * 128 + 8 * h;
#pragma unroll
          for (int ks = 0; ks < 8; ++ks) { const bf16x8 a = *(const bf16x8*)(sp + ks * 16);
            o0 = MFMA32(a, *(const LAS bf16x8*)(qi + r * 136 + ks * 16 + 8 * h), o0); o1 = MFMA32(a, *(const LAS bf16x8*)(qi + (32 + r) * 136 + ks * 16 + 8 * h), o1); } }
        float ss0 = 0.f, ss1 = 0.f;
#pragma unroll
        for (int i = 0; i < 16; ++i) { ss0 += o0[i] * o0[i]; ss1 += o1[i] * o1[i]; }
        ss0 += __shfl_xor(ss0, 32); ss1 += __shfl_xor(ss1, 32);
        if (h == 0) { part[wid * 64 + r] = ss0; part[wid * 64 + 32 + r] = ss1; }
        __syncthreads();
        float t0s = 0.f, t1s = 0.f;
#pragma unroll
        for (int w = 0; w < 8; ++w) { t0s += part[w * 64 + r]; t1s += part[w * 64 + 32 + r]; }
        const float rs0 = 1.f / sqrtf(t0s * (1.f / 256.f) + 1e-6f), rs1 = 1.f / sqrtf(t1s * (1.f / 256.f) + 1e-6f);
#pragma unroll
        for (int gi = 0; gi < 4; ++gi) { const int e0 = 32 * wid + 8 * gi + 4 * h; const f32x4 gn = *(const f32x4*)(g_norm + e0);
#pragma unroll
            for (int nt = 0; nt < 2; ++nt) { bf16_t* yp = proj + (size_t)(t0 + nt * 32 + r) * BINP + 2048 + hh * 256 + e0; const u32x2 rv = *(const u32x2*)yp;
                const float rs = nt ? rs1 : rs0; const float rr[4] = {bflo(rv.x), bfhi(rv.x), bflo(rv.y), bfhi(rv.y)}; const float gv[4] = {gn.x, gn.y, gn.z, gn.w}; float y[4];
#pragma unroll
                for (int jj = 0; jj < 4; ++jj) { const float o = nt ? o1[4 * gi + jj] : o0[4 * gi + jj]; y[jj] = o * rs * gv[jj] * (rr[jj] / (1.f + __expf(-rr[jj]))); }
                u32x2 w2; w2.x = pk2(y[0], y[1]); w2.y = pk2(y[2], y[3]); *(u32x2*)yp = w2; } }
        __syncthreads();
    }
}
struct Args { const float* in[15]; float* out; unsigned char* ws; };
constexpr int CTX_OFF = LDS_BYTES - 256;
DI unsigned long long ctx_ld(LAS unsigned char* lds, int i) {
    volatile LAS unsigned* p = (volatile LAS unsigned*)(lds + CTX_OFF) + 2 * i; unsigned lo = p[0], hi = p[1];
    lo = __builtin_amdgcn_readfirstlane(lo); hi = __builtin_amdgcn_readfirstlane(hi); return ((unsigned long long)hi << 32) | lo;
}
#define CPTR(T, i) ((T)ctx_ld(lds, (i)))
#define GSYNC() cg::this_grid().sync()
__global__ void __launch_bounds__(512, 2) fwd(Args a) {
    extern __shared__ __attribute__((aligned(16))) unsigned char lds_raw[];
    LAS unsigned char* lds = (LAS unsigned char*)(unsigned)0u;
    if ((unsigned)(size_t)(LAS unsigned char*)lds_raw != 0u) return;
    if (threadIdx.x == 0) { LAS unsigned long long* c = (LAS unsigned long long*)(lds + CTX_OFF);
#pragma unroll
        for (int i = 0; i < 15; ++i) c[i] = (unsigned long long)a.in[i];
        c[15] = (unsigned long long)a.out; c[16] = (unsigned long long)a.ws; }
    __syncthreads();
    {
#ifndef NO_P0
            const int tid = my_tid(), lane = tid & 63, wid = __builtin_amdgcn_readfirstlane(tid >> 6), bid = my_bid(), G = gridDim.x;
            const int gw = bid * 8 + wid, ngw = G * 8, gtid = bid * 512 + tid, gt = G * 512;
            unsigned char* ws = CPTR(unsigned char*, 16);
            LAS float* scr = (LAS float*)(lds + wid * 16640);
            for (int j = 0; j < 2; ++j) {
                transpose_matrix(CPTR(const float*, 2) + (size_t)j * 1024 * AIN, 1024, AIN, AINP, (bf16_t*)(ws + OFF_AIN + j * SZ_AIN), scr, gw, ngw, lane);
                transpose_matrix(CPTR(const float*, 3) + (size_t)j * 1024 * 1024, 1024, 1024, 1024, (bf16_t*)(ws + OFF_AO + j * SZ_SQ), scr, gw, ngw, lane);
                transpose_matrix(CPTR(const float*, 4) + (size_t)j * 1024 * BIN, 1024, BIN, BINP, (bf16_t*)(ws + OFF_BIN + j * SZ_BIN), scr, gw, ngw, lane);
                transpose_matrix(CPTR(const float*, 8) + (size_t)j * 1024 * 1024, 1024, 1024, 1024, (bf16_t*)(ws + OFF_BO + j * SZ_SQ), scr, gw, ngw, lane); }
            for (int i = 0; i < 4; ++i) {
                transpose_matrix(CPTR(const float*, 11) + (size_t)i * 1024 * FF, 1024, FF, FF, (bf16_t*)(ws + OFF_UP + i * SZ_FF), scr, gw, ngw, lane);
                transpose_matrix(CPTR(const float*, 12) + (size_t)i * FF * 1024, FF, 1024, 1024, (bf16_t*)(ws + OFF_DN + i * SZ_FF), scr, gw, ngw, lane); }
            rot_table(CPTR(const int*, 1), (float*)(ws + WS_ROT), gtid, gt);
            const float* x = CPTR(const float*, 0); bf16_t* hb = (bf16_t*)(ws + WS_HB);
            for (size_t i = gtid; i < (size_t)NTOK * DM / 8; i += gt) { const f32x4 v0 = ((const f32x4*)x)[2 * i], v1 = ((const f32x4*)x)[2 * i + 1];
                u32x4 w; w.x = pk2(v0.x, v0.y); w.y = pk2(v0.z, v0.w); w.z = pk2(v1.x, v1.y); w.w = pk2(v1.z, v1.w); ((u32x4*)hb)[i] = w; }
#endif
    }
    GSYNC();
    enum { K_P0, K_GB, K_ROT, K_DSA, K_G1, K_G2, K_G3, K_GR, K_LN };
    int s = 0, k = 0;
    for (;;) {
        int kind, cnt;
        if (s & 1) { cnt = 3; kind = k == 0 ? K_GB : k == 1 ? K_GR : K_LN; }
        else if ((s & 2) == 0) { cnt = 5; kind = k == 0 ? K_GB : k == 1 ? K_ROT : k == 2 ? K_DSA : k == 3 ? K_GR : K_LN; }
        else { cnt = 6; kind = k == 0 ? K_GB : k == 1 ? K_G1 : k == 2 ? K_G2 : k == 3 ? K_G3 : k == 4 ? K_GR : K_LN; }
        if (kind == K_GB) {
            const int L = s >> 1, sub = s & 1, mix = L & 1, j = L >> 1;
            unsigned char* ws = CPTR(unsigned char*, 16);
            pg8::Gemm g; pg8::EpiBf16R E;
            g.A = (const bf16_t*)(ws + WS_HB); g.M = NTOK; g.K = 1024; g.lda = 1024; E.O = (bf16_t*)(ws + WS_R);
            if (sub == 0) { g.Bt = mix ? (const bf16_t*)(ws + OFF_BIN + j * SZ_BIN) : (const bf16_t*)(ws + OFF_AIN + j * SZ_AIN); g.N = mix ? BINP : AINP; E.act = 0; }
            else { g.Bt = (const bf16_t*)(ws + OFF_UP + L * SZ_FF); g.N = FF; E.act = 2; }
            E.ldc = g.N;
            pg8::StaticOrder S; S.init(NTOK, g.N, gridDim.x, (int)blockIdx.x);
#ifndef NO_GEMM
            pg8::gemm_phase<pg8::EpiBf16R, pg8::StaticOrder, true, true>(lds, g, S, E);
#endif
        } else if (kind == K_ROT) {
#ifndef NO_ROT
            const int tid = my_tid(), bid = my_bid(); unsigned char* ws = CPTR(unsigned char*, 16);
            rotary_phase((bf16_t*)(ws + WS_R), (const float*)(ws + WS_ROT), bid * 512 + tid, (int)gridDim.x * 512);
#endif
        } else if (kind == K_DSA) {
#ifndef NO_DSA
            unsigned char* ws = CPTR(unsigned char*, 16); dsa_phase(lds, (const bf16_t*)(ws + WS_R), (bf16_t*)(ws + WS_AO));
#endif
        } else if (kind == K_G1) {
#ifndef NO_G1
            const int j = s >> 2; unsigned char* ws = CPTR(unsigned char*, 16);
            gla_g1(lds, (const bf16_t*)(ws + WS_R), CPTR(const float*, 5) + (size_t)j * 16 * 512, CPTR(const float*, 6) + j * 512, (bf16_t*)(ws + WS_DS), (float*)(ws + WS_DEC));
#endif
        } else if (kind == K_G2) {
#ifndef NO_G2
            const int tid = my_tid(), bid = my_bid(); unsigned char* ws = CPTR(unsigned char*, 16);
            gla_g2((bf16_t*)(ws + WS_DS), (const float*)(ws + WS_DEC), bid * 512 + tid, (int)gridDim.x * 512);
#endif
        } else if (kind == K_G3) {
#ifndef NO_G3
            const int j = s >> 2; unsigned char* ws = CPTR(unsigned char*, 16);
            gla_g3(lds, (bf16_t*)(ws + WS_R), CPTR(const float*, 5) + (size_t)j * 16 * 512, CPTR(const float*, 6) + j * 512, CPTR(const float*, 7) + j * 256, (const bf16_t*)(ws + WS_DS));
#endif
        } else if (kind == K_GR) {
            const int L = s >> 1, sub = s & 1, mix = L & 1, j = L >> 1;
            unsigned char* ws = CPTR(unsigned char*, 16); float* out = CPTR(float*, 15);
            pg8::Gemm g; pg8::EpiResid E;
            g.M = NTOK; g.N = 1024;
            if (sub == 0) { g.K = 1024; E.base = (L == 0) ? CPTR(const float*, 0) : out;
                if (mix) { g.A = (const bf16_t*)(ws + WS_R) + 2048; g.lda = BINP; g.Bt = (const bf16_t*)(ws + OFF_BO + j * SZ_SQ); }
                else { g.A = (const bf16_t*)(ws + WS_AO); g.lda = 1024; g.Bt = (const bf16_t*)(ws + OFF_AO + j * SZ_SQ); } }
            else { g.A = (const bf16_t*)(ws + WS_R); g.lda = FF; g.K = FF; g.Bt = (const bf16_t*)(ws + OFF_DN + L * SZ_FF); E.base = out; }
            E.out = out; E.ldc = 1024; E.alpha = DN_ALPHA;
            pg8::StaticOrder S; S.init(NTOK, 1024, gridDim.x, (int)blockIdx.x);
#ifndef NO_GEMM
            pg8::gemm_phase<pg8::EpiResid, pg8::StaticOrder, true, true>(lds, g, S, E);
#endif
        } else {
#ifndef NO_LN
            const int tid = my_tid(), lane = tid & 63, wid = __builtin_amdgcn_readfirstlane(tid >> 6), bid = my_bid();
            const int L = s >> 1, sub = s & 1; unsigned char* ws = CPTR(unsigned char*, 16);
            ln_phase(CPTR(float*, 15), (bf16_t*)(ws + WS_HB), CPTR(const float*, sub ? 13 : 9) + L * 1024, CPTR(const float*, sub ? 14 : 10) + L * 1024, bid * 8 + wid, (int)gridDim.x * 8, lane);
#endif
        }
        if (s == 7 && k == cnt - 1) break;
        GSYNC();
        if (++k == cnt) { k = 0; ++s; }
    }
}
extern "C" void kernel_launch(void* const* d_in, const int* in_sizes, int n_in, void* d_out, int out_size, void* d_ws, size_t ws_size, hipStream_t stream) {
    static int grid = 0;
    if (grid == 0) {
        if (n_in != 15 || out_size != NTOK * DM || ws_size < WS_END) { fprintf(stderr, "kernel_launch: unexpected shapes (n_in %d out %d ws %zu)\n", n_in, out_size, ws_size); grid = -1; return; }
        int dev = 0, cus = 0, per_cu = 0;
        (void)hipGetDevice(&dev); (void)hipDeviceGetAttribute(&cus, hipDeviceAttributeMultiprocessorCount, dev);
        if (hipFuncSetAttribute((const void*)fwd, hipFuncAttributeMaxDynamicSharedMemorySize, LDS_BYTES) != hipSuccess) { fprintf(stderr, "kernel_launch: hipFuncSetAttribute failed\n"); grid = -1; return; }
        if (hipOccupancyMaxActiveBlocksPerMultiprocessor(&per_cu, (const void*)fwd, 512, LDS_BYTES) != hipSuccess || per_cu < 1) { fprintf(stderr, "kernel_launch: occupancy query gave %d\n", per_cu); per_cu = 1; }
        (void)hipGetLastError();
        grid = cus * per_cu;
    }
    if (grid < 0) return;
    Args a{};
    for (int i = 0; i < 15; ++i) a.in[i] = (const float*)d_in[i];
    a.out = (float*)d_out; a.ws = (unsigned char*)d_ws;
    void* args[] = {&a};
    hipError_t e = hipLaunchCooperativeKernel((const void*)fwd, dim3(grid), dim3(512), args, LDS_BYTES, stream);
    if (e != hipSuccess) fprintf(stderr, "kernel_launch: cooperative launch failed: %s (grid %d)\n", hipGetErrorString(e), grid);
}
```

```cpp
#include <hip/hip_runtime.h>
#include <hip/hip_cooperative_groups.h>
#include <cstdio>
#include <cstdint>
namespace cg = cooperative_groups;
namespace pg8 {
#define PG8_LAS __attribute__((address_space(3)))
typedef unsigned short bf16_t;
typedef short bf16x8 __attribute__((ext_vector_type(8)));
typedef float f32x4 __attribute__((ext_vector_type(4)));
typedef unsigned u32x4 __attribute__((ext_vector_type(4)));
constexpr int BM = 256, BK = 64, HALF = 128, HTB = HALF * BK * 2  , STAGE_BYTES = 8 * HTB, NXCD = 8, WGM = 8;

__host__ __device__ __forceinline__ int lds_byte(int r, int c) { const int st = (r >> 4) * 2 + (c >> 5), rr = r & 15, cc = c & 31, ob = rr * 64 + cc * 2; return st * 1024 + (ob ^ (((ob >> 9) & 1) << 5)); }
__host__ __device__ __forceinline__ void stage_rc(int b, int& R, int& C) { const int st = b / 1024, sb = b % 1024, swz = sb ^ (((sb >> 9) & 1) << 5); R = (st >> 1) * 16 + swz / 64; C = (st & 1) * 32 + (swz % 64) / 2; }
__host__ __device__ __forceinline__ int perm32(int rho) { const int n = rho >> 4, i = rho & 15; return 8 * (i >> 2) + 4 * n + (i & 3); }

struct Unit { int pm, pn; };
struct Gemm { const bf16_t* A; const bf16_t* Bt; int M, N, K, lda; };

struct StaticOrder {
    int nM, nN, nwg, G, c;
    __host__ __device__ void init(int M, int N, int G_, int c_) { nM = M / BM; nN = N / BM; nwg = nM * nN; G = G_; c = c_; }
    __host__ __device__ bool next(int i, Unit& u) const {
        const long L = (long)i * G + c; if (L >= nwg) return false;
        int wgid = (int)L; { const int q = nwg / NXCD, r = nwg % NXCD, xcd = wgid % NXCD, off = wgid / NXCD; wgid = (xcd < r ? xcd * (q + 1) : r * (q + 1) + (xcd - r) * q) + off; }
        const int nig = WGM * nN, gid = wgid / nig, fm = gid * WGM, gsz = (nM - fm) < WGM ? (nM - fm) : WGM;
        u.pm = fm + ((wgid % nig) % gsz); u.pn = (wgid % nig) / gsz; return true;
    }
    __device__ __forceinline__ void a_ready(const Unit&) const {}
    __device__ __forceinline__ void done(const Unit&) const {}
};
__device__ __forceinline__ unsigned cvt_pk_bf16(float lo, float hi) { unsigned r; asm volatile("v_cvt_pk_bf16_f32 %0, %1, %2" : "=v"(r) : "v"(lo), "v"(hi)); return r; }
typedef float f32x2 __attribute__((ext_vector_type(2)));
struct EpiBf16R {
    static constexpr bool PERM = true, AFTER_DRAIN = false;
    bf16_t* O; int ldc; int act;
    __device__ __forceinline__ void operator()(const f32x4 (&acc)[2][2][4][2], const Unit& u, int wr, int wc, int fr, int fq) const {
        const int row0 = u.pm * BM + wr * 64 + fr; const int col0 = u.pn * BM + wc * 32 + 8 * fq;
        const f32x4 z4 = (f32x4){0.f, 0.f, 0.f, 0.f};
#pragma unroll
        for (int ai = 0; ai < 2; ++ai)
#pragma unroll
            for (int m = 0; m < 4; ++m) { bf16_t* rowp = O + (size_t)(row0 + ai * HALF + m * 16) * ldc + col0;
#pragma unroll
                for (int bj = 0; bj < 2; ++bj) { f32x4 v0 = acc[ai][bj][m][0], v1 = acc[ai][bj][m][1];
                    if (act) { v0 = __builtin_elementwise_max(v0, z4); v1 = __builtin_elementwise_max(v1, z4); v0 = v0 * v0; v1 = v1 * v1; }
                    u32x4 w; w.x = cvt_pk_bf16(v0[0], v0[1]); w.y = cvt_pk_bf16(v0[2], v0[3]); w.z = cvt_pk_bf16(v1[0], v1[1]); w.w = cvt_pk_bf16(v1[2], v1[3]);
                    *(u32x4*)(rowp + bj * HALF) = w; } }
    }
};
struct EpiResid {
    static constexpr bool PERM = false, AFTER_DRAIN = false;
    const float* base; float* out; int ldc; float alpha;
    __device__ __forceinline__ void operator()(const f32x4 (&acc)[2][2][4][2], const Unit& u, int wr, int wc, int fr, int fq) const {
        const int col0 = u.pn * BM + wc * 32 + 4 * fq;
#pragma unroll
        for (int ai = 0; ai < 2; ++ai)
#pragma unroll
            for (int m = 0; m < 4; ++m) { const size_t off = (size_t)(u.pm * BM + ai * HALF + wr * 64 + m * 16 + fr) * ldc + col0;
#pragma unroll
                for (int bj = 0; bj < 2; ++bj)
#pragma unroll
                    for (int n = 0; n < 2; ++n) { const size_t p = off + bj * HALF + n * 16; const f32x4 bs = *(const f32x4*)(base + p);
                        *(f32x4*)(out + p) = bs * alpha + acc[ai][bj][m][n]; }
                asm volatile("" ::: "memory"); }
    }
};
template <class Epi, class Sched, bool ALIGN_EPI = false, bool SP2 = false>
__device__ __forceinline__ void gemm_phase(PG8_LAS unsigned char* lds, const Gemm g, const Sched& S, const Epi& E) {
    int tid = threadIdx.x; asm volatile("" : "+v"(tid)); const int wid = __builtin_amdgcn_readfirstlane(tid >> 6), lane = tid & 63, wr = wid >> 2, wc = wid & 3, fr = lane & 15, fq = lane >> 4;
    const int K = g.K, nt = K / BK;
    unsigned voffA[2], voffB[2];
#pragma unroll
    for (int i = 0; i < 2; ++i) { int R, C; stage_rc(tid * 16 + i * 8192, R, C); const int Rb = Epi::PERM ? ((R & ~31) + perm32(R & 31)) : R;
        voffA[i] = (unsigned)(R * g.lda + C) * 2u; voffB[i] = (unsigned)(Rb * K + C) * 2u; }
    const size_t kstep = (size_t)(BK * 2);
    const size_t hstep = (size_t)HALF * K * 2; const size_t hstepA = (size_t)HALF * g.lda * 2;
    const size_t tstep = 2 * hstep; const size_t tstepA = 2 * hstepA;
    const unsigned ldsw = (unsigned)wid * 1024u;
    const int aoff = lds_byte(wr * 64 + fr, fq * 8), boff = lds_byte(wc * 32 + fr, fq * 8);
#define PG8_SA(b, h) (((b) * 2 + (h)) * HTB)
#define PG8_SB(b, h) ((4 + (b) * 2 + (h)) * HTB)
#define PG8_STAGE(bufoff, gbase, voff) do { _Pragma("unroll") for (int _i = 0; _i < 2; ++_i) \
        __builtin_amdgcn_global_load_lds((const unsigned*)((const char*)(gbase) + (voff)[_i]), (PG8_LAS unsigned*)(lds + (bufoff) + ldsw + _i * 8192), 16, 0, 0); } while (0)
#define PG8_LDA(dst, b, h) do { _Pragma("unroll") for (int m = 0; m < 4; ++m) _Pragma("unroll") for (int k = 0; k < 2; ++k) dst[m][k] = *(const PG8_LAS bf16x8*)(lds + PG8_SA(b, h) + aoff + m * 2048 + k * 1024); } while (0)
#define PG8_LDB(dst, b, h) do { _Pragma("unroll") for (int n = 0; n < 2; ++n) _Pragma("unroll") for (int k = 0; k < 2; ++k) dst[n][k] = *(const PG8_LAS bf16x8*)(lds + PG8_SB(b, h) + boff + n * 2048 + k * 1024); } while (0)
#define PG8_MMA(ai, bj, At, Bt) do { __builtin_amdgcn_s_setprio(1); _Pragma("unroll") for (int m = 0; m < 4; ++m) _Pragma("unroll") for (int n = 0; n < 2; ++n) _Pragma("unroll") for (int k = 0; k < 2; ++k) \
        acc[ai][bj][m][n] = __builtin_amdgcn_mfma_f32_16x16x32_bf16(Bt[n][k], At[m][k], acc[ai][bj][m][n], 0, 0, 0); __builtin_amdgcn_s_setprio(0); } while (0)
#define PG8_WAIT_V(n) asm volatile("s_waitcnt vmcnt(" #n ")" ::: "memory")
#define PG8_WAIT_L(n) asm volatile("s_waitcnt lgkmcnt(" #n ")" ::: "memory")
#define PG8_BAR __builtin_amdgcn_s_barrier()
#define PG8_SCHED __builtin_amdgcn_sched_barrier(0)
    Unit cur, nxt; int ui = 0;
    if (!S.next(0, cur)) return;
    f32x4 acc[2][2][4][2];
#pragma unroll
    for (int a = 0; a < 2; ++a)
#pragma unroll
        for (int b = 0; b < 2; ++b)
#pragma unroll
            for (int m = 0; m < 4; ++m)
#pragma unroll
                for (int n = 0; n < 2; ++n) acc[a][b][m][n] = (f32x4){0.f, 0.f, 0.f, 0.f};
    bf16x8 At[4][2], B0[2][2], B1[2][2];
    const char* cA = (const char*)g.A + (size_t)cur.pm * tstepA; const char* cB = (const char*)g.Bt + (size_t)cur.pn * tstep;
    S.a_ready(cur);
    if constexpr (SP2) {
        PG8_STAGE(PG8_SB(0, 0), cB, voffB); PG8_STAGE(PG8_SB(0, 1), cB + hstep, voffB); PG8_STAGE(PG8_SA(0, 0), cA, voffA); PG8_STAGE(PG8_SA(0, 1), cA + hstepA, voffA);
        if (wr == 1) PG8_BAR;
        PG8_WAIT_V(2); PG8_BAR;
        PG8_STAGE(PG8_SB(1, 0), cB + kstep, voffB); PG8_STAGE(PG8_SA(1, 0), cA + kstep, voffA); PG8_STAGE(PG8_SB(1, 1), cB + hstep + kstep, voffB);
        PG8_WAIT_V(6); PG8_BAR;
    } else {
        PG8_STAGE(PG8_SB(0, 0), cB, voffB); PG8_STAGE(PG8_SA(0, 0), cA, voffA); PG8_STAGE(PG8_SB(0, 1), cB + hstep, voffB); PG8_STAGE(PG8_SA(0, 1), cA + hstepA, voffA);
        if (wr == 1) PG8_BAR;
        PG8_WAIT_V(4); PG8_BAR;
        PG8_STAGE(PG8_SB(1, 0), cB + kstep, voffB); PG8_STAGE(PG8_SA(1, 0), cA + kstep, voffA); PG8_STAGE(PG8_SB(1, 1), cB + hstep + kstep, voffB);
        PG8_WAIT_V(6); PG8_BAR;
    }
    for (;;) {
        const bool has_next = S.next(ui + 1, nxt);
        const char* nA = has_next ? (const char*)g.A + (size_t)nxt.pm * tstepA : cA; const char* nB = has_next ? (const char*)g.Bt + (size_t)nxt.pn * tstep : cB;
        for (int t = 0; t < nt; t += 2) {
            const bool last = (t == nt - 2);
            const char* a1 = cA + (size_t)(t + 1) * kstep;
            const char* a2 = last ? nA : cA + (size_t)(t + 2) * kstep; const char* b2 = last ? nB : cB + (size_t)(t + 2) * kstep;
            const char* a3 = a2 + kstep; const char* b3 = b2 + kstep;
            if (last && has_next) S.a_ready(nxt);
            if constexpr (SP2) {
            PG8_LDB(B0, 0, 0); PG8_LDB(B1, 0, 1); PG8_SCHED; PG8_LDA(At, 0, 0); PG8_STAGE(PG8_SA(1, 1), a1 + hstepA, voffA);
            PG8_WAIT_V(8); PG8_WAIT_L(0); PG8_BAR; PG8_MMA(0, 0, At, B0); PG8_MMA(0, 1, At, B1); PG8_BAR; PG8_SCHED;
            PG8_LDA(At, 0, 1); PG8_STAGE(PG8_SB(0, 0), b2, voffB); PG8_STAGE(PG8_SB(0, 1), b2 + hstep, voffB); PG8_STAGE(PG8_SA(0, 0), a2, voffA);
            PG8_WAIT_V(8); PG8_WAIT_L(0); PG8_BAR; PG8_MMA(1, 0, At, B0); PG8_MMA(1, 1, At, B1); PG8_BAR; PG8_SCHED;
            PG8_LDB(B0, 1, 0); PG8_LDB(B1, 1, 1); PG8_SCHED; PG8_LDA(At, 1, 0); PG8_STAGE(PG8_SA(0, 1), a2 + hstepA, voffA);
            PG8_WAIT_V(8); PG8_WAIT_L(0); PG8_BAR; PG8_MMA(0, 0, At, B0); PG8_MMA(0, 1, At, B1); PG8_BAR; PG8_SCHED;
            PG8_LDA(At, 1, 1); PG8_STAGE(PG8_SB(1, 0), b3, voffB); PG8_STAGE(PG8_SB(1, 1), b3 + hstep, voffB); PG8_STAGE(PG8_SA(1, 0), a3, voffA);
            PG8_WAIT_V(8); PG8_WAIT_L(0); PG8_BAR; PG8_MMA(1, 0, At, B0); PG8_MMA(1, 1, At, B1); PG8_BAR; PG8_SCHED;
            } else {
            PG8_LDB(B0, 0, 0); PG8_SCHED; PG8_LDA(At, 0, 0); PG8_STAGE(PG8_SA(1, 1), a1 + hstepA, voffA);
            PG8_WAIT_L(8); PG8_BAR; PG8_WAIT_L(0); PG8_MMA(0, 0, At, B0); PG8_BAR; PG8_SCHED;
            PG8_LDB(B1, 0, 1); PG8_STAGE(PG8_SB(0, 0), b2, voffB);
            PG8_BAR; PG8_WAIT_L(0); PG8_MMA(0, 1, At, B1); PG8_BAR;
            PG8_LDA(At, 0, 1); PG8_STAGE(PG8_SA(0, 0), a2, voffA);
            PG8_BAR; PG8_WAIT_L(0); PG8_MMA(1, 0, At, B0); PG8_BAR; PG8_SCHED;
            PG8_STAGE(PG8_SB(0, 1), b2 + hstep, voffB);
            PG8_WAIT_V(6); PG8_BAR; PG8_MMA(1, 1, At, B1); PG8_BAR;
            PG8_LDB(B0, 1, 0); PG8_SCHED; PG8_LDA(At, 1, 0); PG8_STAGE(PG8_SA(0, 1), a2 + hstepA, voffA);
            PG8_WAIT_L(8); PG8_BAR; PG8_WAIT_L(0); PG8_MMA(0, 0, At, B0); PG8_BAR; PG8_SCHED;
            PG8_LDB(B1, 1, 1); PG8_STAGE(PG8_SB(1, 0), b3, voffB);
            PG8_BAR; PG8_WAIT_L(0); PG8_MMA(0, 1, At, B1); PG8_BAR;
            PG8_LDA(At, 1, 1); PG8_STAGE(PG8_SA(1, 0), a3, voffA);
            PG8_BAR; PG8_WAIT_L(0); PG8_MMA(1, 0, At, B0); PG8_BAR; PG8_SCHED;
            PG8_STAGE(PG8_SB(1, 1), b3 + hstep, voffB);
            PG8_WAIT_V(6); PG8_BAR; PG8_MMA(1, 1, At, B1); PG8_BAR;
            }
        }
        if constexpr (ALIGN_EPI) { if (wr == 0) PG8_BAR; }
        if constexpr (!Epi::AFTER_DRAIN) { int t2_ = threadIdx.x; asm volatile("" : "+v"(t2_)); const int w2_ = __builtin_amdgcn_readfirstlane(t2_ >> 6), l2_ = t2_ & 63; E(acc, cur, w2_ >> 2, w2_ & 3, l2_ & 15, l2_ >> 4); S.done(cur); }
        if (!has_next) break;
#pragma unroll
        for (int a = 0; a < 2; ++a)
#pragma unroll
            for (int b = 0; b < 2; ++b)
#pragma unroll
                for (int m = 0; m < 4; ++m)
#pragma unroll
                    for (int n = 0; n < 2; ++n) acc[a][b][m][n] = (f32x4){0.f, 0.f, 0.f, 0.f};
        cur = nxt; cA = nA; cB = nB; ++ui;
        if constexpr (ALIGN_EPI) { if (wr == 1) PG8_BAR; }
    }
    PG8_WAIT_V(0);
    if constexpr (!ALIGN_EPI) { if (wr == 0) PG8_BAR; }
    PG8_BAR;
    if constexpr (Epi::AFTER_DRAIN) { E.fused(acc, cur, wr, wc, fr, fq, lds, wid, lane); S.done(cur); }
#undef PG8_SA
#undef PG8_SB
#undef PG8_STAGE
#undef PG8_LDA
#undef PG8_LDB
#undef PG8_MMA
#undef PG8_WAIT_V
#undef PG8_WAIT_L
#undef PG8_BAR
#undef PG8_SCHED
}
}
#define LAS __attribute__((address_space(3)))
#define DI __device__ __forceinline__
typedef unsigned short bf16_t;
typedef short bf16x8 __attribute__((ext_vector_type(8)));
typedef short s16x4 __attribute__((ext_vector_type(4)));
typedef float f32x4 __attribute__((ext_vector_type(4)));
typedef float f32x16 __attribute__((ext_vector_type(16)));
typedef unsigned u32x4 __attribute__((ext_vector_type(4)));
typedef unsigned u32x2 __attribute__((ext_vector_type(2)));
constexpr int NTOK = 32768, DM = 1024, SEQ = 8192, FF = 4096;
constexpr int AIN = 2120, AINP = 2304, BIN = 3088, BINP = 3328;
constexpr size_t MiB = 1u << 20;
constexpr size_t WS_ROT = 1 * MiB, OFF_AIN = 4 * MiB, OFF_AO = 13 * MiB, OFF_BIN = 17 * MiB, OFF_BO = 30 * MiB, OFF_UP = 34 * MiB, OFF_DN = 66 * MiB;
constexpr size_t WS_HB = 104 * MiB, WS_R = 168 * MiB, WS_AO = 312 * MiB, WS_DS = 376 * MiB, WS_DEC = 504 * MiB, WS_END = 505 * MiB;
constexpr size_t SZ_AIN = (size_t)AINP * 1024 * 2, SZ_BIN = (size_t)BINP * 1024 * 2, SZ_SQ = 2 * MiB, SZ_FF = 8 * MiB;
constexpr int LDS_BYTES = 147456;
constexpr float DN_ALPHA = 1.681792830507429f;

#define LDS_WAIT() asm volatile("s_waitcnt lgkmcnt(0)" ::: "memory")
DI unsigned f2bf(float f) { unsigned u = __float_as_uint(f); return (u + 0x7fffu + ((u >> 16) & 1u)) >> 16; }
DI unsigned pk2(float lo, float hi) { return f2bf(lo) | (f2bf(hi) << 16); }
DI float bflo(unsigned w) { return __uint_as_float(w << 16); }
DI float bfhi(unsigned w) { return __uint_as_float(w & 0xffff0000u); }
DI float bf1(bf16_t b) { return __uint_as_float((unsigned)b << 16); }
DI float wave_sum(float v) {
#pragma unroll
    for (int o = 1; o < 64; o <<= 1) v += __shfl_xor(v, o);
    return v;
}
DI int my_tid() { int t = threadIdx.x; asm volatile("" : "+v"(t)); return t; }
DI int my_bid() { int b = blockIdx.x; asm volatile("" : "+s"(b)); return b; }
DI int my_bid_v() { int b = blockIdx.x; asm volatile("" : "+v"(b)); return b; }
DI int wave_isum(int v) {
#pragma unroll
    for (int o = 1; o < 64; o <<= 1) v += __shfl_xor(v, o);
    return v;
}
DI int crow(int i, int h) { return (i & 3) + 8 * (i >> 2) + 4 * h; }
#define MFMA32(a, b, c) __builtin_amdgcn_mfma_f32_32x32x16_bf16((a), (b), (c), 0, 0, 0)
#define MFMA16(a, b, c) __builtin_amdgcn_mfma_f32_16x16x32_bf16((a), (b), (c), 0, 0, 0)

DI void transpose_matrix(const float* W, int K, int N, int Np, bf16_t* WT, LAS float* scr, int gw, int ngw, int lane) {
    const int nbn = Np >> 6, nit = (K >> 6) * nbn;
    for (int it = gw; it < nit; it += ngw) {
        const int k0 = (it / nbn) << 6, n0 = (it % nbn) << 6;
        const int n = n0 + lane; const bool ok = n < N;
        const float* src = W + (size_t)k0 * N + n;
#pragma unroll 8
        for (int kk = 0; kk < 64; ++kk) scr[kk * 65 + lane] = ok ? src[(size_t)kk * N] : 0.f;
        LDS_WAIT();
        const int c = lane & 7, nr = lane >> 3;
#pragma unroll
        for (int j = 0; j < 8; ++j) { const int nn = nr + 8 * j; const LAS float* s = scr + (8 * c) * 65 + nn;
            u32x4 o; o.x = pk2(s[0], s[65]); o.y = pk2(s[130], s[195]); o.z = pk2(s[260], s[325]); o.w = pk2(s[390], s[455]);
            *(u32x4*)(WT + (size_t)(n0 + nn) * K + k0 + 8 * c) = o; }
        LDS_WAIT();
    }
}
DI void rot_table(const int* pos, float* rot, int gtid, int gt) {
    for (int idx = gtid; idx < NTOK * 8; idx += gt) {
        const int t = idx >> 3, i = idx & 7;
        const double inv = i == 0 ? 1.0 : i == 1 ? 0.19392274474868576 : i == 2 ? 0.03760603093086393 : i == 3 ? 0.007292664737217109 : i == 4 ? 0.001414213562373095 :
                           i == 5 ? 0.0002742481756762073 : i == 6 ? 5.318295896944988e-05 : 1.031338537721246e-05;
        const double x = (double)pos[t] * inv;
        const double n = rint(x * 0.15915494309189535);
        const double r = fma(-n, 6.283185307179586, x) - n * 2.4492935982947064e-16;
        const double r2 = r * r;
        double ts = r, ss = r, tc = 1.0, sc = 1.0;
#pragma unroll
        for (int k = 1; k <= 14; ++k) { ts *= -r2 / (double)((2 * k) * (2 * k + 1)); ss += ts; tc *= -r2 / (double)((2 * k - 1) * (2 * k)); sc += tc; }
        rot[t * 16 + i] = (float)sc; rot[t * 16 + 8 + i] = (float)ss;
    }
}
DI void ln_phase(float* hbuf, bf16_t* hb, const float* g, const float* b, int gw, int ngw, int lane) {
    for (int m = gw; m < NTOK; m += ngw) {
        f32x4* row = (f32x4*)(hbuf + (size_t)m * DM) + lane; f32x4 v[4]; float s = 0.f;
#pragma unroll
        for (int j = 0; j < 4; ++j) { v[j] = row[64 * j]; s += (v[j].x + v[j].y) + (v[j].z + v[j].w); }
        const float mean = wave_sum(s) * (1.f / DM); float s2 = 0.f;
#pragma unroll
        for (int j = 0; j < 4; ++j) { v[j] = v[j] - mean; s2 += (v[j].x * v[j].x + v[j].y * v[j].y) + (v[j].z * v[j].z + v[j].w * v[j].w); }
        const float rstd = 1.f / sqrtf(wave_sum(s2) * (1.f / DM) + 1e-5f);
        u32x2* o8 = (u32x2*)(hb + (size_t)m * DM) + lane;
#pragma unroll
        for (int j = 0; j < 4; ++j) { const f32x4 gg = ((const f32x4*)g)[lane + 64 * j], bb = ((const f32x4*)b)[lane + 64 * j];
            const f32x4 o = v[j] * rstd * gg + bb; row[64 * j] = o; u32x2 w; w.x = pk2(o.x, o.y); w.y = pk2(o.z, o.w); o8[64 * j] = w; }
    }
}
DI void rotary_phase(bf16_t* proj, const float* rot, int gtid, int gt) {
    for (int idx = gtid; idx < NTOK * 29; idx += gt) {
        const int t = idx / 29, hh = idx - t * 29;
        const int col = hh < 16 ? hh * 64 : hh < 20 ? 1024 + (hh - 16) * 64 : hh < 28 ? 1536 + (hh - 20) * 64 : 2048;
        bf16_t* p = proj + (size_t)t * AINP + col;
        const u32x4 a = *(const u32x4*)p, bq = *(const u32x4*)(p + 8);
        const f32x4 c0 = *(const f32x4*)(rot + t * 16), c1 = *(const f32x4*)(rot + t * 16 + 4), s0 = *(const f32x4*)(rot + t * 16 + 8), s1 = *(const f32x4*)(rot + t * 16 + 12);
        u32x4 oa, ob;
#define ROT2(W, CA, SA, CB, SB) { const float t1a = bflo(a.W), t1b = bfhi(a.W), t2a = bflo(bq.W), t2b = bfhi(bq.W); \
        oa.W = pk2(t1a * CA - t2a * SA, t1b * CB - t2b * SB); ob.W = pk2(t2a * CA + t1a * SA, t2b * CB + t1b * SB); }
        ROT2(x, c0.x, s0.x, c0.y, s0.y) ROT2(y, c0.z, s0.z, c0.w, s0.w) ROT2(z, c1.x, s1.x, c1.y, s1.y) ROT2(w, c1.z, s1.z, c1.w, s1.w)
#undef ROT2
        *(u32x4*)p = oa; *(u32x4*)(p + 8) = ob;
    }
}
template <int OFF> DI void tr_read8(unsigned addr, s16x4 (&r)[8]) {
    asm volatile("ds_read_b64_tr_b16 %0, %8 offset:%9\n\tds_read_b64_tr_b16 %1, %8 offset:%10\n\tds_read_b64_tr_b16 %2, %8 offset:%11\n\tds_read_b64_tr_b16 %3, %8 offset:%12\n\t"
                 "ds_read_b64_tr_b16 %4, %8 offset:%13\n\tds_read_b64_tr_b16 %5, %8 offset:%14\n\tds_read_b64_tr_b16 %6, %8 offset:%15\n\tds_read_b64_tr_b16 %7, %8 offset:%16\n\ts_waitcnt lgkmcnt(0)"
                 : "=&v"(r[0]), "=&v"(r[1]), "=&v"(r[2]), "=&v"(r[3]), "=&v"(r[4]), "=&v"(r[5]), "=&v"(r[6]), "=&v"(r[7])
                 : "v"(addr), "n"(OFF), "n"(OFF + 2112), "n"(OFF + 32), "n"(OFF + 32 + 2112), "n"(OFF + 64), "n"(OFF + 64 + 2112), "n"(OFF + 96), "n"(OFF + 96 + 2112) : "memory");
}
constexpr int VROW = 528;
constexpr int D_SAMP = 0, D_CVAL = 32768, D_CIDX = 65536, D_SEL = 135168, D_CTL = 139264, D_CAP = 1024, D_IMG = 16896, D_FBIMG = 32768;
DI unsigned sortable(float v) { const unsigned u = __float_as_uint(v + 0.f); return (u >> 31) ? ~u : (u | 0x80000000u); }
DI void score_tile(const bf16x8 (&a)[4], const bf16x8 (&bb)[4], const float (&w)[4][4], float (&s4)[4]) {
    f32x16 x;
#pragma unroll
    for (int i = 0; i < 16; ++i) x[i] = 0.f;
#pragma unroll
    for (int ks = 0; ks < 4; ++ks) x = MFMA32(a[ks], bb[ks], x);
#pragma unroll
    for (int qq = 0; qq < 4; ++qq) { float s = w[qq][0] * fmaxf(x[4 * qq], 0.f); s += w[qq][1] * fmaxf(x[4 * qq + 1], 0.f); s += w[qq][2] * fmaxf(x[4 * qq + 2], 0.f); s += w[qq][3] * fmaxf(x[4 * qq + 3], 0.f);
        s += __shfl_xor(s, 32); s4[qq] = s; }
}
DI void load_iq(const bf16_t* proj, int tokr, int r, int h, bf16x8 (&a)[4], float (&w)[4][4]) {
    const bf16_t* p = proj + (size_t)(tokr + (r >> 3)) * AINP + 1536 + (r & 7) * 64 + 8 * h;
#pragma unroll
    for (int ks = 0; ks < 4; ++ks) a[ks] = *(const bf16x8*)(p + ks * 16);
#pragma unroll
    for (int qq = 0; qq < 4; ++qq) { const u32x2 wv = *(const u32x2*)(proj + (size_t)(tokr + qq) * AINP + 2112 + 4 * h);
        const float sc_ = 0.35355339059327373f * 0.125f; w[qq][0] = bflo(wv.x) * sc_; w[qq][1] = bfhi(wv.x) * sc_; w[qq][2] = bflo(wv.y) * sc_; w[qq][3] = bfhi(wv.y) * sc_; }
}
DI void load_ik(const bf16_t* kp0, int kt, bf16x8 (&bb)[4]) {
    const bf16_t* kp = kp0 + (size_t)(kt * 32) * AINP;
#pragma unroll
    for (int ks = 0; ks < 4; ++ks) bb[ks] = *(const bf16x8*)(kp + ks * 16);
}
DI void full_select(const LAS unsigned* row, int nround, LAS unsigned short* sl, int lane) {
    asm volatile("" : "+v"(lane));
    unsigned T = 0u;
    for (int bit = 31; bit >= 0; --bit) { const unsigned cand = T | (1u << bit); int cnt = 0;
#pragma unroll 4
        for (int i = lane * 4; i < nround; i += 256) { const u32x4 v = *(const LAS u32x4*)(row + i);
            cnt += (int)(v.x >= cand) + (int)(v.y >= cand) + (int)(v.z >= cand) + (int)(v.w >= cand); }
        cnt = wave_isum(cnt); if (cnt >= 256) T = cand; }
    int cgt = 0;
#pragma unroll 4
    for (int i = lane * 4; i < nround; i += 256) { const u32x4 v = *(const LAS u32x4*)(row + i);
        cgt += (int)(v.x > T) + (int)(v.y > T) + (int)(v.z > T) + (int)(v.w > T); }
    cgt = wave_isum(cgt);
    const int need = 256 - cgt; int base = 0, eqb = 0; const unsigned long long ltm = (1ull << lane) - 1ull;
    for (int i0 = 0; i0 < nround; i0 += 64) { const unsigned u = row[i0 + lane]; const bool gt = u > T, eq = u == T;
        const unsigned long long me = __ballot(eq); const bool take = gt || (eq && (eqb + __popcll(me & ltm)) < need);
        const unsigned long long mt = __ballot(take); if (take) sl[base + __popcll(mt & ltm)] = (unsigned short)(i0 + lane);
        base += __popcll(mt); eqb += __popcll(me); }
}
DI void dsa_attend(const bf16_t* proj, bf16_t* ao, int tok, int b, int nsel, const LAS unsigned short* sl, LAS unsigned char* vimg, int lane) {
    asm volatile("" : "+v"(lane));
    const int fr = lane & 15, fq = lane >> 4;
    bf16x8 qa, qb, qz;
    { const bf16_t* qp = proj + (size_t)tok * AINP + fr * 64 + fq * 8; qa = *(const bf16x8*)qp; qb = *(const bf16x8*)(qp + 32);
#pragma unroll
      for (int i = 0; i < 8; ++i) qz[i] = 0; }
    const int qg = fr >> 2;
#define QF(st) ((((st) >> 1) == qg) ? (((st) & 1) ? qb : qa) : qz)
    const bf16_t* kbase = proj + (size_t)(b * SEQ) * AINP + 1024 + fq * 8;
    const int ntl = (nsel + 15) >> 4;
    f32x4 sacc[16];
#pragma unroll
    for (int jt = 0; jt < 16; ++jt) {
        f32x4 acc = (f32x4){0.f, 0.f, 0.f, 0.f};
        if (jt < ntl) { const int kidx = sl[jt * 16 + fr]; const bf16_t* kr = kbase + (size_t)kidx * AINP;
#pragma unroll
            for (int st = 0; st < 8; ++st) acc = MFMA16(*(const bf16x8*)(kr + st * 32), QF(st), acc); }
#pragma unroll
        for (int j = 0; j < 4; ++j) if (jt * 16 + 4 * fq + j >= nsel) acc[j] = -INFINITY;
        sacc[jt] = acc;
    }
#undef QF
    float mx = -INFINITY;
#pragma unroll
    for (int jt = 0; jt < 16; ++jt) mx = fmaxf(mx, fmaxf(fmaxf(sacc[jt][0], sacc[jt][1]), fmaxf(sacc[jt][2], sacc[jt][3])));
    mx = fmaxf(mx, __shfl_xor(mx, 16)); mx = fmaxf(mx, __shfl_xor(mx, 32));
    float sum = 0.f; bf16x8 pf[8];
#pragma unroll
    for (int s = 0; s < 8; ++s) { float p[8];
#pragma unroll
        for (int j = 0; j < 4; ++j) { p[j] = __builtin_amdgcn_exp2f((sacc[2 * s][j] - mx) * (0.125f * 1.4426950408889634f)); p[4 + j] = __builtin_amdgcn_exp2f((sacc[2 * s + 1][j] - mx) * (0.125f * 1.4426950408889634f)); }
        u32x4 pw; pw.x = pk2(p[0], p[1]); pw.y = pk2(p[2], p[3]); pw.z = pk2(p[4], p[5]); pw.w = pk2(p[6], p[7]);
        sum += ((p[0] + p[1]) + (p[2] + p[3])) + ((p[4] + p[5]) + (p[6] + p[7]));
        pf[s] = __builtin_bit_cast(bf16x8, pw); }
    sum += __shfl_xor(sum, 16); sum += __shfl_xor(sum, 32);
    const float inv = 1.f / sum;
    f32x4 oacc[16];
#pragma unroll
    for (int dt = 0; dt < 16; ++dt) oacc[dt] = (f32x4){0.f, 0.f, 0.f, 0.f};
    const bf16_t* vbase = proj + (size_t)(b * SEQ) * AINP + 1280 + (lane & 31) * 8;
    const unsigned traddr = (unsigned)(size_t)vimg + (unsigned)((8 * fq + ((lane >> 2) & 3)) * VROW + 8 * (lane & 3));
    u32x4 vld[16];
#define VGATHER(S) { _Pragma("unroll") for (int u = 0; u < 16; ++u) { const int rho = u * 2 + (lane >> 5); const int fqr = rho >> 3, j = rho & 7; \
        const int pos = (2 * (S) + (j >> 2)) * 16 + 4 * fqr + (j & 3); const int kidx = sl[pos]; vld[u] = *(const u32x4*)(vbase + (size_t)kidx * AINP); } }
    VGATHER(0)
#pragma unroll
    for (int s = 0; s < 8; ++s) {
        if (2 * s < ntl) {
#pragma unroll
            for (int u = 0; u < 16; ++u) { const int rho = u * 2 + (lane >> 5); *(LAS u32x4*)(vimg + rho * VROW + (lane & 31) * 16) = vld[u]; }
            if (s < 7) { if (2 * (s + 1) < ntl) VGATHER(s + 1) }
            LDS_WAIT();
            s16x4 t8[8];
#define PV4(T0) tr_read8<(T0) * 32>(traddr, t8); \
            oacc[T0] = MFMA16(pf[s], __builtin_shufflevector(t8[0], t8[1], 0, 1, 2, 3, 4, 5, 6, 7), oacc[T0]); \
            oacc[T0 + 1] = MFMA16(pf[s], __builtin_shufflevector(t8[2], t8[3], 0, 1, 2, 3, 4, 5, 6, 7), oacc[T0 + 1]); \
            oacc[T0 + 2] = MFMA16(pf[s], __builtin_shufflevector(t8[4], t8[5], 0, 1, 2, 3, 4, 5, 6, 7), oacc[T0 + 2]); \
            oacc[T0 + 3] = MFMA16(pf[s], __builtin_shufflevector(t8[6], t8[7], 0, 1, 2, 3, 4, 5, 6, 7), oacc[T0 + 3]);
            PV4(0) PV4(4) PV4(8) PV4(12)
#undef PV4
        }
    }
#undef VGATHER
    float ivj[4];
#pragma unroll
    for (int j = 0; j < 4; ++j) ivj[j] = __shfl(inv, 4 * fq + j);
#pragma unroll
    for (int dt = 0; dt < 16; ++dt) if (fq == (dt >> 2)) {
#pragma unroll
        for (int j = 0; j < 4; ++j) ao[(size_t)tok * DM + (4 * fq + j) * 64 + (dt & 3) * 16 + fr] = (bf16_t)f2bf(oacc[dt][j] * ivj[j]); }
}
#define CNT16(V, EXPR) ({ int c_ = 0; _Pragma("unroll") for (int i_ = 0; i_ < 16; ++i_) { const unsigned x_ = V[i_]; (void)x_; c_ += __popcll(__ballot(EXPR)); } c_; })
DI void dsa_phase(LAS unsigned char* lds, const bf16_t* proj, bf16_t* ao) {
    LAS unsigned* samp = (LAS unsigned*)(lds + D_SAMP); LAS unsigned* cval = (LAS unsigned*)(lds + D_CVAL); LAS unsigned short* cidx = (LAS unsigned short*)(lds + D_CIDX);
    LAS unsigned short* sel = (LAS unsigned short*)(lds + D_SEL); LAS unsigned* ctl = (LAS unsigned*)(lds + D_CTL);
    const int tid0 = my_tid(), wid = __builtin_amdgcn_readfirstlane(tid0 >> 6);
    const int bid0 = my_bid(), G0 = gridDim.x; const bool xmap = (G0 == 256);
    const int gfirst = xmap ? ((bid0 & 7) >> 1) * 1024 + (bid0 >> 3) + 32 * (bid0 & 1) : bid0, gstep = xmap ? 64 : G0, gend = xmap ? ((bid0 & 7) >> 1) * 1024 + 1024 : NTOK / 8;
    for (int g = gfirst; g < gend; g += gstep) {
        int lane = tid0 & 63; asm volatile("" : "+v"(lane));
        const int r = lane & 31, h = lane >> 5, tid = wid * 64 + lane;
        const int tok0 = g * 8, b = tok0 >> 13, s0 = tok0 & (SEQ - 1);
        const int ntile = (s0 + 8 + 31) >> 5;
        const bf16_t* kp0 = proj + (size_t)(b * SEQ + r) * AINP + 2048 + 8 * h;
        bf16x8 a0[4], a1[4]; float w0[4][4], w1[4][4];
        load_iq(proj, tok0, r, h, a0, w0); load_iq(proj, tok0 + 4, r, h, a1, w1);
        for (int st = wid; st < 32; st += 8) {
            const int kt = (st >> 1) * 16 + (st & 1); const int key = kt * 32 + r;
            unsigned u[4] = {0u, 0u, 0u, 0u};
            if (kt < ntile) { bf16x8 bb[4]; load_ik(kp0, kt, bb); float s4[4];
                score_tile(a0, bb, w0, s4); u[0] = sortable(h ? s4[2] : s4[0]); u[1] = sortable(h ? s4[3] : s4[1]);
                score_tile(a1, bb, w1, s4); u[2] = sortable(h ? s4[2] : s4[0]); u[3] = sortable(h ? s4[3] : s4[1]); }
#pragma unroll
            for (int e = 0; e < 4; ++e) { const int q = 4 * (e >> 1) + 2 * h + (e & 1); samp[q * 1024 + st * 32 + r] = (key > s0 + q) ? 0u : u[e]; }
        }
        __syncthreads();
        {   const int q = wid, n = s0 + q + 1; unsigned thr = 1u;
            if (n > 1024) { const int rem = n & 511; const int ns = 64 * (n >> 9) + (rem < 64 ? rem : 64); int rs = (448 * ns + n - 1) / n; rs = rs < 8 ? 8 : rs;
                unsigned sv[16];
#pragma unroll
                for (int i = 0; i < 16; ++i) sv[i] = samp[q * 1024 + lane + 64 * i];
                unsigned T = 0u;
                for (int bit = 31; bit >= 0; --bit) { const unsigned cand = T | (1u << bit); const int c = CNT16(sv, x_ >= cand); if (c >= rs) T = cand; }
                thr = T > 1u ? T : 1u; }
            if (lane == 0) { ctl[q] = thr; ctl[16 + q] = 0u; } }
        __syncthreads();
        {   unsigned th[4], cl[4] = {0u, 0u, 0u, 0u}, ch[4] = {0u, 0u, 0u, 0u};
#pragma unroll
            for (int e = 0; e < 4; ++e) th[e] = ctl[4 * (e >> 1) + 2 * h + (e & 1)];
            bf16x8 bb[4]; load_ik(kp0, wid < ntile ? wid : ntile - 1, bb);
            for (int kt = wid; kt < ntile; kt += 8) {
                bf16x8 nb[4]; load_ik(kp0, (kt + 8 < ntile) ? kt + 8 : ntile - 1, nb);
                const int key = kt * 32 + r; unsigned u[4]; float s4[4];
                score_tile(a0, bb, w0, s4); u[0] = sortable(h ? s4[2] : s4[0]); u[1] = sortable(h ? s4[3] : s4[1]);
                score_tile(a1, bb, w1, s4); u[2] = sortable(h ? s4[2] : s4[0]); u[3] = sortable(h ? s4[3] : s4[1]);
#pragma unroll
                for (int e = 0; e < 4; ++e) { const int q = 4 * (e >> 1) + 2 * h + (e & 1); const unsigned uu = (key > s0 + q) ? 0u : u[e];
                    const bool pass = uu >= th[e]; const unsigned long long m = __ballot(pass);
                    if (m) { const unsigned mlo = (unsigned)m, mhi = (unsigned)(m >> 32); const unsigned mh = h ? mhi : mlo, base = h ? ch[e] : cl[e];
                        if (pass) { const unsigned p = base + __popc(mh & ((1u << r) - 1u)); if (p < 128u) { const int ix = q * D_CAP + wid * 128 + (int)p; cval[ix] = uu; cidx[ix] = (unsigned short)key; } }
                        cl[e] += __popc(mlo); ch[e] += __popc(mhi); } }
#pragma unroll
                for (int ks = 0; ks < 4; ++ks) bb[ks] = nb[ks];
            }
            if (lane == 0) {
#pragma unroll
                for (int e = 0; e < 4; ++e) { ctl[24 + (4 * (e >> 1) + (e & 1)) * 8 + wid] = cl[e]; ctl[24 + (4 * (e >> 1) + 2 + (e & 1)) * 8 + wid] = ch[e]; } } }
        __syncthreads();
        int nsel = 0; bool fb = false;
        {   asm volatile("" : "+v"(lane)); const unsigned long long ltm = (1ull << lane) - 1ull;
            const int q = wid; LAS unsigned short* sl = sel + q * 256; const unsigned thr = ctl[q];
            unsigned cw[8], cnt = 0u; bool ovf = false;
#pragma unroll
            for (int w = 0; w < 8; ++w) { cw[w] = ctl[24 + q * 8 + w]; cnt += cw[w]; ovf = ovf || (cw[w] > 128u); }
            if (ovf || (thr > 1u && cnt < 256u)) { fb = true; if (lane == 0) ctl[16 + q] = 1u; }
            else { unsigned cv[16], ci[16];
#pragma unroll
                for (int i = 0; i < 16; ++i) { const unsigned o = (i & 1) * 64 + lane; const bool in = o < cw[i >> 1]; const int ix = q * D_CAP + (i >> 1) * 128 + (int)o;
                    cv[i] = in ? cval[ix] : 0u; ci[i] = in ? (unsigned)cidx[ix] : 0xffffu; }
                unsigned T = 0u, I = 0xffffu;
                if (cnt <= 256u) nsel = (int)cnt;
                else { nsel = 256;
                    for (int bit = 31; bit >= 0; --bit) { const unsigned cand = T | (1u << bit); const int c = CNT16(cv, x_ >= cand); if (c >= 256) T = cand; }
                    const int cgt = CNT16(cv, x_ > T), ceq = CNT16(cv, x_ == T), need = 256 - cgt;
                    if (ceq > need) { I = 0u;
                        for (int bit = 13; bit >= 0; --bit) { const unsigned cand = I | (1u << bit); int c = 0;
#pragma unroll
                            for (int i = 0; i < 16; ++i) c += __popcll(__ballot(cv[i] == T && ci[i] < cand));
                            if (c < need) I = cand; } } }
                int base = 0;
#pragma unroll
                for (int i = 0; i < 16; ++i) { const bool take = cv[i] > T || (cv[i] == T && ci[i] <= I && T != 0u); const unsigned long long mt = __ballot(take);
                    if (take) sl[base + __popcll(mt & ltm)] = (unsigned short)ci[i]; base += __popcll(mt); }
#pragma unroll
                for (int i = 0; i < 4; ++i) { const int p = lane + 64 * i; if (p >= nsel) sl[p] = (unsigned short)0; } }
            LDS_WAIT(); }
        __syncthreads();
        if (!fb) dsa_attend(proj, ao, tok0 + wid, b, nsel, sel + wid * 256, lds + wid * D_IMG, lane);
        __syncthreads();
        for (int q = 0; q < 8; ++q) {
            if (ctl[16 + q] == 0u) continue;
            LAS unsigned* row = (LAS unsigned*)lds; const int n = s0 + q + 1, ntq = (n + 31) >> 5, nround = (ntq * 32 + 255) & ~255;
            bf16x8 af[4]; float wf[4][4]; load_iq(proj, tok0 + (q & 4), r, h, af, wf);
            for (int kt = wid; kt < ntq; kt += 8) { bf16x8 bb[4]; load_ik(kp0, kt, bb); float s4[4];
                score_tile(af, bb, wf, s4);
                const int key = kt * 32 + r; const int ql = q & 3; const float sv = (ql == 0) ? s4[0] : (ql == 1) ? s4[1] : (ql == 2) ? s4[2] : s4[3];
                if (h == 0) row[key] = (key >= n) ? 0u : sortable(sv); }
            for (int i = ntq * 32 + tid; i < nround; i += 512) row[i] = 0u;
            __syncthreads();
            if (wid == 0) { full_select(row, nround, sel, lane); LDS_WAIT(); dsa_attend(proj, ao, tok0 + q, b, 256, sel, lds + D_FBIMG, lane); }
            __syncthreads();
        }
    }
}
constexpr int G_ALOW = 0, G_BC = 4096, G_TOT = 36864, G_KST = 38912, G_VT = 57344, G_QI = 94208, G_KI = 111616, G_AT = 129024, G_PART = 138240;
DI void gla_gate(LAS unsigned char* lds, const bf16_t* proj, const float* w_a2, const float* b_a, int t0, int hh, int tid) {
    LAS float* alow = (LAS float*)(lds + G_ALOW); LAS float* bc = (LAS float*)(lds + G_BC); LAS float* tot = (LAS float*)(lds + G_TOT);
    for (int i = tid; i < 1024; i += 512) alow[i] = bf1(proj[(size_t)(t0 + (i >> 4)) * BINP + 3072 + (i & 15)]);
    __syncthreads();
    const int d = tid & 127, jg = tid >> 7;
    float wv[16];
#pragma unroll
    for (int rr = 0; rr < 16; ++rr) wv[rr] = w_a2[rr * 512 + hh * 128 + d];
    const float bias = b_a[hh * 128 + d];
    float gl[16]; float run = 0.f;
#pragma unroll
    for (int jj = 0; jj < 16; ++jj) { const LAS f32x4* ap = (const LAS f32x4*)(alow + (jg * 16 + jj) * 16); float z = bias;
#pragma unroll
        for (int q4 = 0; q4 < 4; ++q4) { const f32x4 av = ap[q4]; z += av.x * wv[4 * q4] + av.y * wv[4 * q4 + 1] + av.z * wv[4 * q4 + 2] + av.w * wv[4 * q4 + 3]; }
        const float ls = fminf(z, 0.f) - __logf(1.f + __expf(-fabsf(z)));
        run += ls * 0.0625f; gl[jj] = run; }
    tot[jg * 128 + d] = run;
    __syncthreads();
    float off = 0.f;
#pragma unroll
    for (int q = 0; q < 3; ++q) if (q < jg) off += tot[q * 128 + d];
#pragma unroll
    for (int jj = 0; jj < 16; ++jj) bc[(jg * 16 + jj) * 128 + d] = off + gl[jj];
    __syncthreads();
}
DI void gla_load_vt(LAS unsigned char* lds, const bf16_t* proj, int t0, int hh, int tid) {
    LAS bf16_t* vt = (LAS bf16_t*)(lds + G_VT);
    for (int it = tid; it < 2048; it += 512) { const int j = it >> 5, e0 = (it & 31) * 8;
        const u32x4 vv = *(const u32x4*)(proj + (size_t)(t0 + j) * BINP + 1024 + hh * 256 + e0);
        vt[(e0 + 0) * 72 + j] = (bf16_t)(vv.x & 0xffffu); vt[(e0 + 1) * 72 + j] = (bf16_t)(vv.x >> 16); vt[(e0 + 2) * 72 + j] = (bf16_t)(vv.y & 0xffffu); vt[(e0 + 3) * 72 + j] = (bf16_t)(vv.y >> 16);
        vt[(e0 + 4) * 72 + j] = (bf16_t)(vv.z & 0xffffu); vt[(e0 + 5) * 72 + j] = (bf16_t)(vv.z >> 16); vt[(e0 + 6) * 72 + j] = (bf16_t)(vv.w & 0xffffu); vt[(e0 + 7) * 72 + j] = (bf16_t)(vv.w >> 16); }
}
DI void gla_g1(LAS unsigned char* lds, const bf16_t* proj, const float* w_a2, const float* b_a, bf16_t* DS, float* DEC) {
    const int tid = my_tid(), wid = tid >> 6, lane = tid & 63, r = lane & 31, h = lane >> 5;
    LAS float* bc = (LAS float*)(lds + G_BC); LAS bf16_t* kst = (LAS bf16_t*)(lds + G_KST); LAS bf16_t* vt = (LAS bf16_t*)(lds + G_VT);
    for (int unit = my_bid_v(); unit < 2048; unit += gridDim.x) {
        const int b = unit >> 9, hh = (unit >> 7) & 3, c = unit & 127, t0 = b * SEQ + c * 64;
        gla_gate(lds, proj, w_a2, b_a, t0, hh, tid);
        for (int it = tid; it < 1024; it += 512) { const int j = it >> 4, d0 = (it & 15) * 8;
            const u32x4 kv = *(const u32x4*)(proj + (size_t)(t0 + j) * BINP + 512 + hh * 128 + d0);
            const unsigned kw[4] = {kv.x, kv.y, kv.z, kv.w};
#pragma unroll
            for (int i = 0; i < 8; ++i) { const int d = d0 + i; const float kf = (i & 1) ? bfhi(kw[i >> 1]) : bflo(kw[i >> 1]);
                kst[d * 72 + j] = (bf16_t)f2bf(kf * __expf(bc[63 * 128 + d] - bc[j * 128 + d])); } }
        gla_load_vt(lds, proj, t0, hh, tid);
        if (tid < 128) DEC[(size_t)unit * 128 + tid] = __expf(bc[63 * 128 + tid]);
        __syncthreads();
        bf16x8 a[4];
#pragma unroll
        for (int ks = 0; ks < 4; ++ks) a[ks] = *(const LAS bf16x8*)(vt + (32 * wid + r) * 72 + ks * 16 + 8 * h);
#pragma unroll
        for (int nt = 0; nt < 4; ++nt) { f32x16 x;
#pragma unroll
            for (int i = 0; i < 16; ++i) x[i] = 0.f;
#pragma unroll
            for (int ks = 0; ks < 4; ++ks) x = MFMA32(a[ks], *(const LAS bf16x8*)(kst + (nt * 32 + r) * 72 + ks * 16 + 8 * h), x);
#pragma unroll
            for (int i = 0; i < 16; ++i) DS[((size_t)unit * 256 + 32 * wid + crow(i, h)) * 128 + nt * 32 + r] = (bf16_t)f2bf(x[i]); }
        __syncthreads();
    }
}
DI void gla_g2(bf16_t* DS, const float* DEC, int gtid, int gt) {
    for (int idx = gtid; idx < 131072; idx += gt) {
        const int bh = idx >> 13, e = (idx >> 5) & 255, d0 = (idx & 31) * 4;
        bf16_t* p = DS + ((size_t)(bh * 128) * 256 + e) * 128 + d0; const float* dp = DEC + (size_t)bh * 128 * 128 + d0;
        float S0 = 0.f, S1 = 0.f, S2 = 0.f, S3 = 0.f;
#pragma unroll 8
        for (int c = 0; c < 128; ++c) { const u32x2 v = *(const u32x2*)(p + (size_t)c * 32768); const f32x4 dc = *(const f32x4*)(dp + c * 128);
            u32x2 o; o.x = pk2(S0, S1); o.y = pk2(S2, S3); *(u32x2*)(p + (size_t)c * 32768) = o;
            S0 = dc.x * S0 + bflo(v.x); S1 = dc.y * S1 + bfhi(v.x); S2 = dc.z * S2 + bflo(v.y); S3 = dc.w * S3 + bfhi(v.y); }
    }
}
DI void gla_g3(LAS unsigned char* lds, bf16_t* proj, const float* w_a2, const float* b_a, const float* g_norm, const bf16_t* DS) {
    const int tid = my_tid(), wid = tid >> 6, lane = tid & 63, r = lane & 31, h = lane >> 5;
    LAS float* bc = (LAS float*)(lds + G_BC); LAS bf16_t* vt = (LAS bf16_t*)(lds + G_VT); LAS bf16_t* qi = (LAS bf16_t*)(lds + G_QI); LAS bf16_t* ki = (LAS bf16_t*)(lds + G_KI);
    LAS bf16_t* at = (LAS bf16_t*)(lds + G_AT); LAS float* part = (LAS float*)(lds + G_PART);
    for (int unit = my_bid_v(); unit < 2048; unit += gridDim.x) {
        const int b = unit >> 9, hh = (unit >> 7) & 3, c = unit & 127, t0 = b * SEQ + c * 64;
        gla_gate(lds, proj, w_a2, b_a, t0, hh, tid);
        for (int it = tid; it < 1024; it += 512) { const int j = it >> 4, d0 = (it & 15) * 8;
            const bf16_t* rp = proj + (size_t)(t0 + j) * BINP + hh * 128 + d0;
            const u32x4 qv = *(const u32x4*)rp, kv = *(const u32x4*)(rp + 512);
            const f32x4 b0 = *(const LAS f32x4*)(bc + j * 128 + d0), b1 = *(const LAS f32x4*)(bc + j * 128 + d0 + 4);
            const float bv[8] = {b0.x, b0.y, b0.z, b0.w, b1.x, b1.y, b1.z, b1.w};
            const unsigned qw[4] = {qv.x, qv.y, qv.z, qv.w}, kw[4] = {kv.x, kv.y, kv.z, kv.w};
            float qo[8], ko[8];
#pragma unroll
            for (int i = 0; i < 8; ++i) { const float qf = (i & 1) ? bfhi(qw[i >> 1]) : bflo(qw[i >> 1]), kf = (i & 1) ? bfhi(kw[i >> 1]) : bflo(kw[i >> 1]);
                qo[i] = qf * 0.08838834764831845f * __expf(bv[i]); ko[i] = kf * __expf(-bv[i]); }
            u32x4 qp, kp; qp.x = pk2(qo[0], qo[1]); qp.y = pk2(qo[2], qo[3]); qp.z = pk2(qo[4], qo[5]); qp.w = pk2(qo[6], qo[7]);
            kp.x = pk2(ko[0], ko[1]); kp.y = pk2(ko[2], ko[3]); kp.z = pk2(ko[4], ko[5]); kp.w = pk2(ko[6], ko[7]);
            *(LAS u32x4*)(qi + j * 136 + d0) = qp; *(LAS u32x4*)(ki + j * 136 + d0) = kp; }
        gla_load_vt(lds, proj, t0, hh, tid);
        __syncthreads();
        if (wid < 4) { const int it_ = wid >> 1, jt = wid & 1; f32x16 x;
#pragma unroll
            for (int i = 0; i < 16; ++i) x[i] = 0.f;
#pragma unroll
            for (int ks = 0; ks < 8; ++ks) x = MFMA32(*(const LAS bf16x8*)(qi + (it_ * 32 + r) * 136 + ks * 16 + 8 * h), *(const LAS bf16x8*)(ki + (jt * 32 + r) * 136 + ks * 16 + 8 * h), x);
#pragma unroll
            for (int i = 0; i < 16; ++i) { const int ii = it_ * 32 + crow(i, h), jj = jt * 32 + r; at[ii * 72 + jj] = (bf16_t)((jj <= ii) ? f2bf(x[i]) : 0u); } }
        __syncthreads();
        f32x16 o0, o1;
#pragma unroll
        for (int i = 0; i < 16; ++i) { o0[i] = 0.f; o1[i] = 0.f; }
#pragma unroll
        for (int ks = 0; ks < 4; ++ks) { const bf16x8 a = *(const LAS bf16x8*)(vt + (32 * wid + r) * 72 + ks * 16 + 8 * h);
            o0 = MFMA32(a, *(const LAS bf16x8*)(at + r * 72 + ks * 16 + 8 * h), o0); o1 = MFMA32(a, *(const LAS bf16x8*)(at + (32 + r) * 72 + ks * 16 + 8 * h), o1); }
        { const bf16_t* sp = DS + ((size_t)unit * 256 + 32 * wid + r) * 128 + 8 * h;
#pragma unroll
          for (int ks = 0; ks < 8; ++ks) { const bf16x8 a = *(const bf16x8*)(sp + ks * 16);
            o0 = MFMA32(a, *(const LAS bf16x8*)(qi + r * 136 + ks * 16 + 8 * h), o0); o1 = MFMA32(a, *(const LAS bf16x8*)(qi + (32 + r) * 136 + ks * 16 + 8 * h), o1); } }
        float ss0 = 0.f, ss1 = 0.f;
#pragma unroll
        for (int i = 0; i < 16; ++i) { ss0 += o0[i] * o0[i]; ss1 += o1[i] * o1[i]; }
        ss0 += __shfl_xor(ss0, 32); ss1 += __shfl_xor(ss1, 32);
        if (h == 0) { part[wid * 64 + r] = ss0; part[wid * 64 + 32 + r] = ss1; }
        __syncthreads();
        float t0s = 0.f, t1s = 0.f;
#pragma unroll
        for (int w = 0; w < 8; ++w) { t0s += part[w * 64 + r]; t1s += part[w * 64 + 32 + r]; }
        const float rs0 = 1.f / sqrtf(t0s * (1.f / 256.f) + 1e-6f), rs1 = 1.f / sqrtf(t1s * (1.f / 256.f) + 1e-6f);
#pragma unroll
        for (int gi = 0; gi < 4; ++gi) { const int e0 = 32 * wid + 8 * gi + 4 * h; const f32x4 gn = *(const f32x4*)(g_norm + e0);
#pragma unroll
            for (int nt = 0; nt < 2; ++nt) { bf16_t* yp = proj + (size_t)(t0 + nt * 32 + r) * BINP + 2048 + hh * 256 + e0; const u32x2 rv = *(const u32x2*)yp;
                const float rs = nt ? rs1 : rs0; const float rr[4] = {bflo(rv.x), bfhi(rv.x), bflo(rv.y), bfhi(rv.y)}; const float gv[4] = {gn.x, gn.y, gn.z, gn.w}; float y[4];
#pragma unroll
                for (int jj = 0; jj < 4; ++jj) { const float o = nt ? o1[4 * gi + jj] : o0[4 * gi + jj]; y[jj] = o * rs * gv[jj] * (rr[jj] / (1.f + __expf(-rr[jj]))); }
                u32x2 w2; w2.x = pk2(y[0], y[1]); w2.y = pk2(y[2], y[3]); *(u32x2*)yp = w2; } }
        __syncthreads();
    }
}
#define XB_TMO      128
#define XB_XCNT(j)  (256  + 64 * (j))
#define XB_XSUB(j)  (1280 + 64 * (j))
#define XB_XGEN(j)  (2304 + 64 * (j))
#define XB_TOP      3328
#define XB_TOPGEN   3392
#define XCD_BAR_WORDS 3456
#define XB_SPIN_CAP (1u << 18)

__device__ __forceinline__ unsigned xb_ld(unsigned* p)              { return __hip_atomic_load(p, __ATOMIC_RELAXED, __HIP_MEMORY_SCOPE_AGENT); }
__device__ __forceinline__ unsigned xb_add(unsigned* p, unsigned v) { return __hip_atomic_fetch_add(p, v, __ATOMIC_RELAXED, __HIP_MEMORY_SCOPE_AGENT); }
__device__ __forceinline__ unsigned xb_xcc_id() { return (unsigned)__builtin_amdgcn_s_getreg((3 << 11) | 20) & 0xFu; }
#define XB_SPIN(cond, bar) do { unsigned _sp = 0; while (cond) { __builtin_amdgcn_s_sleep(1); \
    if ((++_sp & 255u) == 0u) { if (xb_ld(&(bar)[XB_TMO])) break; if (_sp > XB_SPIN_CAP) { atomicAdd(&(bar)[XB_TMO], 1u); break; } } } } while (0)

struct XcdBarrier {
    unsigned* bar; unsigned x;
    volatile LAS unsigned* st;
};

__device__ __forceinline__ XcdBarrier xcd_barrier_post(unsigned* bar, volatile LAS unsigned* st) {
    XcdBarrier b; b.bar = bar; b.x = xb_xcc_id(); b.st = st;
    if (threadIdx.x == 0) (void)xb_add(&bar[XB_XCNT(b.x)], 1u);
    return b;
}
__device__ __forceinline__ void xcd_barrier_complete(unsigned* bar, unsigned x, unsigned& nloc, unsigned& nx) {
    const unsigned G = gridDim.x * gridDim.y * gridDim.z;
    unsigned sum, cnt, mine, sp = 0u;
    for (;;) {
        sum = 0u; cnt = 0u; mine = 0u;
#pragma unroll
        for (unsigned j = 0; j < 16; ++j) { const unsigned c = xb_ld(&bar[XB_XCNT(j)]); sum += c; cnt += (c > 0u) ? 1u : 0u; mine = (j == x) ? c : mine; }
        if (sum == G) break;
        __builtin_amdgcn_s_sleep(1);
        if ((++sp & 255u) == 0u) { if (xb_ld(&bar[XB_TMO])) break; if (sp > XB_SPIN_CAP) { atomicAdd(&bar[XB_TMO], 1u); break; } }
    }
    nloc = mine > 0u ? mine : 1u; nx = cnt > 0u ? cnt : 1u;
}

__device__ __forceinline__ void xcd_barrier(const XcdBarrier& b) {
    asm volatile("s_waitcnt vmcnt(0)" ::: "memory");
    __syncthreads();
    if (threadIdx.x == 0) {
        unsigned* bar = b.bar;
        __builtin_amdgcn_s_waitcnt(0);
        unsigned nloc = b.st[0], nx = b.st[1];
        if (nloc == 0u) { xcd_barrier_complete(bar, b.x, nloc, nx); b.st[0] = nloc; b.st[1] = nx; }
        const unsigned old = xb_add(&bar[XB_XSUB(b.x)], 1u);
        const unsigned gen = old / nloc;
        if (old + 1u == (gen + 1u) * nloc) {
            __builtin_amdgcn_fence(__ATOMIC_RELEASE, "agent");
            asm volatile("s_waitcnt vmcnt(0)" ::: "memory");
            const unsigned og = xb_add(&bar[XB_TOP], 1u);
            const unsigned tg = og / nx;
            if (og + 1u == (tg + 1u) * nx) xb_add(&bar[XB_TOPGEN], 1u);
            else XB_SPIN(xb_ld(&bar[XB_TOPGEN]) == tg, bar);
            __builtin_amdgcn_fence(__ATOMIC_ACQUIRE, "agent");
            xb_add(&bar[XB_XGEN(b.x)], 1u);
            asm volatile("s_waitcnt vmcnt(0)" ::: "memory");
        } else {
            XB_SPIN(xb_ld(&bar[XB_XGEN(b.x)]) == gen, bar);
            __builtin_amdgcn_fence(__ATOMIC_ACQUIRE, "agent");
            asm volatile("s_waitcnt vmcnt(0)" ::: "memory");
        }
    }
    __syncthreads();
}

struct Args { const float* in[15]; float* out; unsigned char* ws; };
constexpr int CTX_OFF = LDS_BYTES - 256;
DI unsigned long long ctx_ld(LAS unsigned char* lds, int i) {
    volatile LAS unsigned* p = (volatile LAS unsigned*)(lds + CTX_OFF) + 2 * i; unsigned lo = p[0], hi = p[1];
    lo = __builtin_amdgcn_readfirstlane(lo); hi = __builtin_amdgcn_readfirstlane(hi); return ((unsigned long long)hi << 32) | lo;
}
#define CPTR(T, i) ((T)ctx_ld(lds, (i)))
#define GSYNC_CG() cg::this_grid().sync()
#define XB_LDS_OFF (CTX_OFF + 208)
#define GSYNC() { XcdBarrier xb_; xb_.bar = CPTR(unsigned*, 16); xb_.x = xb_xcc_id(); xb_.st = (volatile LAS unsigned*)(lds + XB_LDS_OFF); xcd_barrier(xb_); }
__global__ void __launch_bounds__(512, 2) fwd(Args a) {
    extern __shared__ __attribute__((aligned(16))) unsigned char lds_raw[];
    LAS unsigned char* lds = (LAS unsigned char*)(unsigned)0u;
    if ((unsigned)(size_t)(LAS unsigned char*)lds_raw != 0u) return;
    if (threadIdx.x == 0) { LAS unsigned long long* c = (LAS unsigned long long*)(lds + CTX_OFF);
#pragma unroll
        for (int i = 0; i < 15; ++i) c[i] = (unsigned long long)a.in[i];
        c[15] = (unsigned long long)a.out; c[16] = (unsigned long long)a.ws;
        ((LAS unsigned*)(lds + XB_LDS_OFF))[0] = 0u; ((LAS unsigned*)(lds + XB_LDS_OFF))[1] = 0u; }
    __syncthreads();
    (void)xcd_barrier_post(CPTR(unsigned*, 16), (volatile LAS unsigned*)(lds + XB_LDS_OFF));
    {
#ifndef NO_P0
            const int tid = my_tid(), lane = tid & 63, wid = __builtin_amdgcn_readfirstlane(tid >> 6), bid = my_bid(), G = gridDim.x;
            const int gw = bid * 8 + wid, ngw = G * 8, gtid = bid * 512 + tid, gt = G * 512;
            unsigned char* ws = CPTR(unsigned char*, 16);
            LAS float* scr = (LAS float*)(lds + wid * 16640);
            for (int j = 0; j < 2; ++j) {
                transpose_matrix(CPTR(const float*, 2) + (size_t)j * 1024 * AIN, 1024, AIN, AINP, (bf16_t*)(ws + OFF_AIN + j * SZ_AIN), scr, gw, ngw, lane);
                transpose_matrix(CPTR(const float*, 3) + (size_t)j * 1024 * 1024, 1024, 1024, 1024, (bf16_t*)(ws + OFF_AO + j * SZ_SQ), scr, gw, ngw, lane);
                transpose_matrix(CPTR(const float*, 4) + (size_t)j * 1024 * BIN, 1024, BIN, BINP, (bf16_t*)(ws + OFF_BIN + j * SZ_BIN), scr, gw, ngw, lane);
                transpose_matrix(CPTR(const float*, 8) + (size_t)j * 1024 * 1024, 1024, 1024, 1024, (bf16_t*)(ws + OFF_BO + j * SZ_SQ), scr, gw, ngw, lane); }
            for (int i = 0; i < 4; ++i) {
                transpose_matrix(CPTR(const float*, 11) + (size_t)i * 1024 * FF, 1024, FF, FF, (bf16_t*)(ws + OFF_UP + i * SZ_FF), scr, gw, ngw, lane);
                transpose_matrix(CPTR(const float*, 12) + (size_t)i * FF * 1024, FF, 1024, 1024, (bf16_t*)(ws + OFF_DN + i * SZ_FF), scr, gw, ngw, lane); }
            rot_table(CPTR(const int*, 1), (float*)(ws + WS_ROT), gtid, gt);
            const float* x = CPTR(const float*, 0); bf16_t* hb = (bf16_t*)(ws + WS_HB);
            for (size_t i = gtid; i < (size_t)NTOK * DM / 8; i += gt) { const f32x4 v0 = ((const f32x4*)x)[2 * i], v1 = ((const f32x4*)x)[2 * i + 1];
                u32x4 w; w.x = pk2(v0.x, v0.y); w.y = pk2(v0.z, v0.w); w.z = pk2(v1.x, v1.y); w.w = pk2(v1.z, v1.w); ((u32x4*)hb)[i] = w; }
#endif
    }
    GSYNC_CG();
    enum { K_P0, K_GB, K_ROT, K_DSA, K_G1, K_G2, K_G3, K_GR, K_LN };
    int s = 0, k = 0;
    for (;;) {
        int kind, cnt;
        if (s & 1) { cnt = 3; kind = k == 0 ? K_GB : k == 1 ? K_GR : K_LN; }
        else if ((s & 2) == 0) { cnt = 5; kind = k == 0 ? K_GB : k == 1 ? K_ROT : k == 2 ? K_DSA : k == 3 ? K_GR : K_LN; }
        else { cnt = 6; kind = k == 0 ? K_GB : k == 1 ? K_G1 : k == 2 ? K_G2 : k == 3 ? K_G3 : k == 4 ? K_GR : K_LN; }
        if (kind == K_GB) {
            const int L = s >> 1, sub = s & 1, mix = L & 1, j = L >> 1;
            unsigned char* ws = CPTR(unsigned char*, 16);
            pg8::Gemm g; pg8::EpiBf16R E;
            g.A = (const bf16_t*)(ws + WS_HB); g.M = NTOK; g.K = 1024; g.lda = 1024; E.O = (bf16_t*)(ws + WS_R);
            if (sub == 0) { g.Bt = mix ? (const bf16_t*)(ws + OFF_BIN + j * SZ_BIN) : (const bf16_t*)(ws + OFF_AIN + j * SZ_AIN); g.N = mix ? BINP : AINP; E.act = 0; }
            else { g.Bt = (const bf16_t*)(ws + OFF_UP + L * SZ_FF); g.N = FF; E.act = 2; }
            E.ldc = g.N;
            pg8::StaticOrder S; S.init(NTOK, g.N, gridDim.x, (int)blockIdx.x);
#ifndef NO_GEMM
            pg8::gemm_phase<pg8::EpiBf16R, pg8::StaticOrder, true, true>(lds, g, S, E);
#endif
        } else if (kind == K_ROT) {
#ifndef NO_ROT
            const int tid = my_tid(), bid = my_bid(); unsigned char* ws = CPTR(unsigned char*, 16);
            rotary_phase((bf16_t*)(ws + WS_R), (const float*)(ws + WS_ROT), bid * 512 + tid, (int)gridDim.x * 512);
#endif
        } else if (kind == K_DSA) {
#ifndef NO_DSA
            unsigned char* ws = CPTR(unsigned char*, 16); dsa_phase(lds, (const bf16_t*)(ws + WS_R), (bf16_t*)(ws + WS_AO));
#endif
        } else if (kind == K_G1) {
#ifndef NO_G1
            const int j = s >> 2; unsigned char* ws = CPTR(unsigned char*, 16);
            gla_g1(lds, (const bf16_t*)(ws + WS_R), CPTR(const float*, 5) + (size_t)j * 16 * 512, CPTR(const float*, 6) + j * 512, (bf16_t*)(ws + WS_DS), (float*)(ws + WS_DEC));
#endif
        } else if (kind == K_G2) {
#ifndef NO_G2
            const int tid = my_tid(), bid = my_bid(); unsigned char* ws = CPTR(unsigned char*, 16);
            gla_g2((bf16_t*)(ws + WS_DS), (const float*)(ws + WS_DEC), bid * 512 + tid, (int)gridDim.x * 512);
#endif
        } else if (kind == K_G3) {
#ifndef NO_G3
            const int j = s >> 2; unsigned char* ws = CPTR(unsigned char*, 16);
            gla_g3(lds, (bf16_t*)(ws + WS_R), CPTR(const float*, 5) + (size_t)j * 16 * 512, CPTR(const float*, 6) + j * 512, CPTR(const float*, 7) + j * 256, (const bf16_t*)(ws + WS_DS));
#endif
        } else if (kind == K_GR) {
            const int L = s >> 1, sub = s & 1, mix = L & 1, j = L >> 1;
            unsigned char* ws = CPTR(unsigned char*, 16); float* out = CPTR(float*, 15);
            pg8::Gemm g; pg8::EpiResid E;
            g.M = NTOK; g.N = 1024;
            if (sub == 0) { g.K = 1024; E.base = (L == 0) ? CPTR(const float*, 0) : out;
                if (mix) { g.A = (const bf16_t*)(ws + WS_R) + 2048; g.lda = BINP; g.Bt = (const bf16_t*)(ws + OFF_BO + j * SZ_SQ); }
                else { g.A = (const bf16_t*)(ws + WS_AO); g.lda = 1024; g.Bt = (const bf16_t*)(ws + OFF_AO + j * SZ_SQ); } }
            else { g.A = (const bf16_t*)(ws + WS_R); g.lda = FF; g.K = FF; g.Bt = (const bf16_t*)(ws + OFF_DN + L * SZ_FF); E.base = out; }
            E.out = out; E.ldc = 1024; E.alpha = DN_ALPHA;
            pg8::StaticOrder S; S.init(NTOK, 1024, gridDim.x, (int)blockIdx.x);
#ifndef NO_GEMM
            pg8::gemm_phase<pg8::EpiResid, pg8::StaticOrder, true, true>(lds, g, S, E);
#endif
        } else {
#ifndef NO_LN
            const int tid = my_tid(), lane = tid & 63, wid = __builtin_amdgcn_readfirstlane(tid >> 6), bid = my_bid();
            const int L = s >> 1, sub = s & 1; unsigned char* ws = CPTR(unsigned char*, 16);
            ln_phase(CPTR(float*, 15), (bf16_t*)(ws + WS_HB), CPTR(const float*, sub ? 13 : 9) + L * 1024, CPTR(const float*, sub ? 14 : 10) + L * 1024, bid * 8 + wid, (int)gridDim.x * 8, lane);
#endif
        }
        if (s == 7 && k == cnt - 1) break;
        GSYNC();
        if (++k == cnt) { k = 0; ++s; }
    }
}
extern "C" void kernel_launch(void* const* d_in, const int* in_sizes, int n_in, void* d_out, int out_size, void* d_ws, size_t ws_size, hipStream_t stream) {
    static int grid = 0;
    if (grid == 0) {
        if (n_in != 15 || out_size != NTOK * DM || ws_size < WS_END) { fprintf(stderr, "kernel_launch: unexpected shapes (n_in %d out %d ws %zu)\n", n_in, out_size, ws_size); grid = -1; return; }
        int dev = 0, cus = 0, per_cu = 0;
        (void)hipGetDevice(&dev); (void)hipDeviceGetAttribute(&cus, hipDeviceAttributeMultiprocessorCount, dev);
        if (hipFuncSetAttribute((const void*)fwd, hipFuncAttributeMaxDynamicSharedMemorySize, LDS_BYTES) != hipSuccess) { fprintf(stderr, "kernel_launch: hipFuncSetAttribute failed\n"); grid = -1; return; }
        if (hipOccupancyMaxActiveBlocksPerMultiprocessor(&per_cu, (const void*)fwd, 512, LDS_BYTES) != hipSuccess || per_cu < 1) { fprintf(stderr, "kernel_launch: occupancy query gave %d\n", per_cu); per_cu = 1; }
        (void)hipGetLastError();
        grid = cus * per_cu;
    }
    if (grid < 0) return;
    if (hipMemsetAsync(d_ws, 0, 16384, stream) != hipSuccess) { fprintf(stderr, "kernel_launch: memset of the barrier words failed\n"); return; }
    Args a{};
    for (int i = 0; i < 15; ++i) a.in[i] = (const float*)d_in[i];
    a.out = (float*)d_out; a.ws = (unsigned char*)d_ws;
    void* args[] = {&a};
    hipError_t e = hipLaunchCooperativeKernel((const void*)fwd, dim3(grid), dim3(512), args, LDS_BYTES, stream);
    if (e != hipSuccess) fprintf(stderr, "kernel_launch: cooperative launch failed: %s (grid %d)\n", hipGetErrorString(e), grid);
}
```
